# Optimizing an MI355X kernel written in HIP

```python
import jax, jax.numpy as jnp
from jax import lax
import numpy as np

D_MODEL = 1024
BATCH = 8
SEQ = 2048
DEPTH = 1

N_HEADS = 8
HEAD_DIM = 64
ATTN_WIDTH = N_HEADS * HEAD_DIM
IDX_HEADS = 8
IDX_DIM = 64
TOPK_MAX = 256
Q_BLOCK = 128
POOL_WINDOWS = (2, 4, 8, 16)
POOL_GROUPS = len(POOL_WINDOWS)
POOL_GROUP_DIM = 128
POOL_WIDTH = POOL_GROUPS * POOL_GROUP_DIM
D_FF = 2816
ROPE_THETA = 10000.0
EPS = 1e-6

SPLITS = (ATTN_WIDTH, HEAD_DIM, HEAD_DIM, IDX_HEADS * IDX_DIM, IDX_DIM, IDX_HEADS,
          POOL_WIDTH, D_MODEL, D_MODEL)
D_IN = sum(SPLITS)
SPLIT_POINTS = [int(c) for c in np.cumsum(SPLITS)[:-1]]

kernel_name = "hybrid_dsa_pool_macaron_block"


def rms_norm(x, g):
    xf = x.astype(jnp.float32)
    y = xf * lax.rsqrt(jnp.mean(xf * xf, axis=-1, keepdims=True) + EPS)
    return (y * g.astype(jnp.float32)).astype(x.dtype)


def rope_tables(positions, dim):
    inv_freq = ROPE_THETA ** (-jnp.arange(0, dim, 2, dtype=jnp.float32) / dim)
    ang = positions.astype(jnp.float32)[..., None] * inv_freq
    return jnp.cos(ang), jnp.sin(ang)


def apply_rope(x, cos, sin):
    xf = x.astype(jnp.float32)
    half = xf.shape[-1] // 2
    x1, x2 = xf[..., :half], xf[..., half:]
    return jnp.concatenate([x1 * cos - x2 * sin, x2 * cos + x1 * sin], axis=-1).astype(x.dtype)


def swiglu(h, w1, w3, w2):
    return (jax.nn.silu(h @ w1) * (h @ w3)) @ w2


def dsa_attention(q, k, v, qi, ki, wi, topk):
    B, S = q.shape[0], q.shape[1]
    n_blocks = S // Q_BLOCK
    scale = HEAD_DIM ** -0.5
    idx_scale = (IDX_DIM ** -0.5) * (IDX_HEADS ** -0.5)
    key_pos = jnp.arange(S)
    gather = jax.vmap(lambda t, i: t[i])

    def block(bi):
        start = bi * Q_BLOCK
        qb = lax.dynamic_slice_in_dim(q, start, Q_BLOCK, axis=1)
        qib = lax.dynamic_slice_in_dim(qi, start, Q_BLOCK, axis=1)
        wib = lax.dynamic_slice_in_dim(wi, start, Q_BLOCK, axis=1)
        qpos = start + jnp.arange(Q_BLOCK)
        causal = key_pos[None, :] <= qpos[:, None]
        dots = jnp.einsum('bqhd,bsd->bqhs', qib, ki).astype(jnp.float32)
        score = jnp.einsum('bqhs,bqh->bqs', jax.nn.relu(dots), wib.astype(jnp.float32)) * idx_scale
        score = jnp.where(causal[None], score, -jnp.inf)
        _, sel = lax.top_k(score, topk)
        valid = sel <= qpos[None, :, None]
        ks = gather(k, sel)
        vs = gather(v, sel)
        logits = jnp.einsum('bqhd,bqkd->bqhk', qb, ks).astype(jnp.float32) * scale
        logits = jnp.where(valid[:, :, None, :], logits, -jnp.inf)
        p = jax.nn.softmax(logits, axis=-1).astype(v.dtype)
        return jnp.einsum('bqhk,bqkd->bqhd', p, vs)

    out = lax.map(block, jnp.arange(n_blocks))
    return out.transpose(1, 0, 2, 3, 4).reshape(B, S, N_HEADS * HEAD_DIM)


def multiscale_pool(u, w, b, scale):
    B, S = u.shape[0], u.shape[1]
    ug = u.reshape(B, S, POOL_GROUPS, POOL_GROUP_DIM)
    count_base = jnp.arange(1, S + 1, dtype=jnp.float32)[None, :, None]
    outs = []
    for g, win in enumerate(POOL_WINDOWS):
        xg = ug[:, :, g].astype(jnp.float32)
        c = jnp.cumsum(xg, axis=1)
        lag = jnp.pad(c[:, :-win], ((0, 0), (win, 0), (0, 0)))
        mean = (c - lag) / jnp.minimum(count_base, float(win))
        outs.append(mean - xg)
    pooled = jnp.stack(outs, axis=2).astype(u.dtype)
    mixed = jnp.einsum('bsgc,gcd->bsgd', pooled, w) + b
    return mixed.reshape(B, S, POOL_WIDTH) * scale


def setup_inputs(seed: int = 0) -> dict:
    key = jax.random.key(seed)
    ks = jax.random.split(key, 24)
    L = DEPTH
    f32 = jnp.float32

    def nrm(k, shape, fan_in):
        return jax.random.normal(k, shape, f32) * (fan_in ** -0.5)

    def gain(k, shape):
        return 1.0 + 0.02 * jax.random.normal(k, shape, f32)

    return {
        "x": jax.random.normal(ks[0], (BATCH, SEQ, D_MODEL), f32),
        "positions": jnp.broadcast_to(jnp.arange(SEQ, dtype=jnp.int32), (BATCH, SEQ)),
        "ffn1_norm": gain(ks[1], (L, D_MODEL)),
        "ffn1_w1": nrm(ks[2], (L, D_MODEL, D_FF), D_MODEL),
        "ffn1_w3": nrm(ks[3], (L, D_MODEL, D_FF), D_MODEL),
        "ffn1_w2": nrm(ks[4], (L, D_FF, D_MODEL), D_FF),
        "mix_norm": gain(ks[5], (L, D_MODEL)),
        "w_in": nrm(ks[6], (L, D_MODEL, D_IN), D_MODEL),
        "q_norm": gain(ks[7], (L, HEAD_DIM)),
        "k_norm": gain(ks[8], (L, HEAD_DIM)),
        "pool_w": nrm(ks[9], (L, POOL_GROUPS, POOL_GROUP_DIM, POOL_GROUP_DIM), POOL_GROUP_DIM),
        "pool_b": 0.02 * jax.random.normal(ks[10], (L, POOL_GROUPS, POOL_GROUP_DIM), f32),
        "pool_scale": gain(ks[11], (L, POOL_WIDTH)),
        "proj_attn": nrm(ks[12], (L, ATTN_WIDTH, D_MODEL), ATTN_WIDTH),
        "proj_pool": nrm(ks[13], (L, POOL_WIDTH, D_MODEL), POOL_WIDTH),
        "w_out": nrm(ks[14], (L, D_MODEL, D_MODEL), D_MODEL),
        "ffn2_norm": gain(ks[15], (L, D_MODEL)),
        "ffn2_w1": nrm(ks[16], (L, D_MODEL, D_FF), D_MODEL),
        "ffn2_w3": nrm(ks[17], (L, D_MODEL, D_FF), D_MODEL),
        "ffn2_w2": nrm(ks[18], (L, D_FF, D_MODEL), D_FF),
    }


def reference(x, positions, ffn1_norm, ffn1_w1, ffn1_w3, ffn1_w2, mix_norm, w_in, q_norm, k_norm,
              pool_w, pool_b, pool_scale, proj_attn, proj_pool, w_out,
              ffn2_norm, ffn2_w1, ffn2_w3, ffn2_w2):
    B, S = x.shape[0], x.shape[1]
    topk = min(TOPK_MAX, S // 4)
    cos, sin = rope_tables(positions, HEAD_DIM)
    cos_h, sin_h = cos[:, :, None, :], sin[:, :, None, :]

    for l in range(DEPTH):
        x = x + 0.5 * swiglu(rms_norm(x, ffn1_norm[l]), ffn1_w1[l], ffn1_w3[l], ffn1_w2[l])

        h = rms_norm(x, mix_norm[l])
        z = h @ w_in[l]
        q, k, v, qi, ki, wi, u, g_attn, g_pool = jnp.split(z, SPLIT_POINTS, axis=-1)

        q = apply_rope(rms_norm(q.reshape(B, S, N_HEADS, HEAD_DIM), q_norm[l]), cos_h, sin_h)
        k = apply_rope(rms_norm(k, k_norm[l]), cos, sin)
        qi = apply_rope(qi.reshape(B, S, IDX_HEADS, IDX_DIM), cos_h, sin_h)
        ki = apply_rope(ki, cos, sin)
        y_attn = dsa_attention(q, k, v, qi, ki, wi, topk)

        y_pool = multiscale_pool(u, pool_w[l], pool_b[l], pool_scale[l])

        merged = (jax.nn.sigmoid(g_attn) * (y_attn @ proj_attn[l])
                  + jax.nn.sigmoid(g_pool) * (y_pool @ proj_pool[l]))
        x = x + merged @ w_out[l]

        x = x + 0.5 * swiglu(rms_norm(x, ffn2_norm[l]), ffn2_w1[l], ffn2_w3[l], ffn2_w2[l])
    return x
```

```cpp
#include <hip/hip_runtime.h>
#include <hip/hip_cooperative_groups.h>
#include <cstdio>
namespace cg = cooperative_groups;
namespace pg8 {
#define PG8_LAS __attribute__((address_space(3)))
typedef unsigned short bf16_t;
typedef short bf16x8 __attribute__((ext_vector_type(8)));
typedef float f32x4 __attribute__((ext_vector_type(4)));
typedef unsigned u32x4 __attribute__((ext_vector_type(4)));
constexpr int BM = 256, BK = 64, HALF = 128, HTB = HALF * BK * 2  , STAGE_BYTES = 8 * HTB, NXCD = 8, WGM = 8;

__host__ __device__ __forceinline__ int lds_byte(int r, int c) { const int st = (r >> 4) * 2 + (c >> 5), rr = r & 15, cc = c & 31, ob = rr * 64 + cc * 2; return st * 1024 + (ob ^ (((ob >> 9) & 1) << 5)); }
__host__ __device__ __forceinline__ void stage_rc(int b, int& R, int& C) { const int st = b / 1024, sb = b % 1024, swz = sb ^ (((sb >> 9) & 1) << 5); R = (st >> 1) * 16 + swz / 64; C = (st & 1) * 32 + (swz % 64) / 2; }
__host__ __device__ __forceinline__ int perm32(int rho) { const int n = rho >> 4, i = rho & 15; return 8 * (i >> 2) + 4 * n + (i & 3); }

struct Unit { int pm, pn; };
struct Gemm { const bf16_t* A; const bf16_t* Bt; int M, N, K; };

struct StaticOrder {
    int nM, nN, nwg, G, c;
    __host__ __device__ void init(int M, int N, int G_, int c_) { nM = M / BM; nN = N / BM; nwg = nM * nN; G = G_; c = c_; }
    __host__ __device__ bool next(int i, Unit& u) const {
        const long L = (long)i * G + c; if (L >= nwg) return false;
        int wgid = (int)L; { const int q = nwg / NXCD, r = nwg % NXCD, xcd = wgid % NXCD, off = wgid / NXCD; wgid = (xcd < r ? xcd * (q + 1) : r * (q + 1) + (xcd - r) * q) + off; }
        const int nig = WGM * nN, gid = wgid / nig, fm = gid * WGM, gsz = (nM - fm) < WGM ? (nM - fm) : WGM;
        u.pm = fm + ((wgid % nig) % gsz); u.pn = (wgid % nig) / gsz; return true;
    }
    __device__ __forceinline__ void a_ready(const Unit&) const {}
    __device__ __forceinline__ void done(const Unit&) const {}
};
__device__ __forceinline__ unsigned cvt_pk_bf16(float lo, float hi) { unsigned r; asm volatile("v_cvt_pk_bf16_f32 %0, %1, %2" : "=v"(r) : "v"(lo), "v"(hi)); return r; }
template <class Epi, class Sched, bool STAMP = false>
__device__ __forceinline__ void gemm_phase(PG8_LAS unsigned char* lds, const Gemm g, const Sched& S, const Epi& E, unsigned long long* stamps) {
    const int tid = threadIdx.x, wid = __builtin_amdgcn_readfirstlane(tid >> 6), lane = tid & 63, wr = wid >> 2, wc = wid & 3, fr = lane & 15, fq = lane >> 4;
    const int K = g.K, nt = K / BK;
    int ts_lo = 0, ts_hi = 0, nts = 0; const unsigned long long rt_entry = STAMP ? (unsigned long long)wall_clock64() : 0ull;
#define PG8_STAMP() do { if (STAMP && wid == 0 && nts < 64) { const unsigned long long _c = (unsigned long long)clock64(); \
        ts_lo = (lane == nts) ? (int)(unsigned)_c : ts_lo; ts_hi = (lane == nts) ? (int)(unsigned)(_c >> 32) : ts_hi; ++nts; } } while (0)
    PG8_STAMP();
    unsigned voffA[2], voffB[2];
#pragma unroll
    for (int i = 0; i < 2; ++i) { int R, C; stage_rc(tid * 16 + i * 8192, R, C); const int Rb = Epi::PERM ? ((R & ~31) + perm32(R & 31)) : R;
        voffA[i] = (unsigned)(R * K + C) * 2u; voffB[i] = (unsigned)(Rb * K + C) * 2u; }
    const size_t kstep = (size_t)(BK * 2);
    const size_t hstep = (size_t)HALF * K * 2;
    const size_t tstep = 2 * hstep;
    const unsigned ldsw = (unsigned)wid * 1024u;
    const int aoff = lds_byte(wr * 64 + fr, fq * 8), boff = lds_byte(wc * 32 + fr, fq * 8);
#define PG8_SA(b, h) (((b) * 2 + (h)) * HTB)
#define PG8_SB(b, h) ((4 + (b) * 2 + (h)) * HTB)
#define PG8_STAGE(bufoff, gbase, voff) do { _Pragma("unroll") for (int _i = 0; _i < 2; ++_i) \
        __builtin_amdgcn_global_load_lds((const unsigned*)((const char*)(gbase) + (voff)[_i]), (PG8_LAS unsigned*)(lds + (bufoff) + ldsw + _i * 8192), 16, 0, 0); } while (0)
#define PG8_LDA(dst, b, h) do { _Pragma("unroll") for (int m = 0; m < 4; ++m) _Pragma("unroll") for (int k = 0; k < 2; ++k) dst[m][k] = *(const PG8_LAS bf16x8*)(lds + PG8_SA(b, h) + aoff + m * 2048 + k * 1024); } while (0)
#define PG8_LDB(dst, b, h) do { _Pragma("unroll") for (int n = 0; n < 2; ++n) _Pragma("unroll") for (int k = 0; k < 2; ++k) dst[n][k] = *(const PG8_LAS bf16x8*)(lds + PG8_SB(b, h) + boff + n * 2048 + k * 1024); } while (0)
#define PG8_MMA(ai, bj, At, Bt) do { __builtin_amdgcn_s_setprio(1); _Pragma("unroll") for (int m = 0; m < 4; ++m) _Pragma("unroll") for (int n = 0; n < 2; ++n) _Pragma("unroll") for (int k = 0; k < 2; ++k) \
        acc[ai][bj][m][n] = __builtin_amdgcn_mfma_f32_16x16x32_bf16(Bt[n][k], At[m][k], acc[ai][bj][m][n], 0, 0, 0); __builtin_amdgcn_s_setprio(0); } while (0)
#define PG8_WAIT_V(n) asm volatile("s_waitcnt vmcnt(" #n ")" ::: "memory")
#define PG8_WAIT_L(n) asm volatile("s_waitcnt lgkmcnt(" #n ")" ::: "memory")
#define PG8_BAR __builtin_amdgcn_s_barrier()
#define PG8_SCHED __builtin_amdgcn_sched_barrier(0)
    Unit cur, nxt; int ui = 0;
    if (!S.next(0, cur)) return;
    f32x4 acc[2][2][4][2];
#pragma unroll
    for (int a = 0; a < 2; ++a)
#pragma unroll
        for (int b = 0; b < 2; ++b)
#pragma unroll
            for (int m = 0; m < 4; ++m)
#pragma unroll
                for (int n = 0; n < 2; ++n) acc[a][b][m][n] = (f32x4){0.f, 0.f, 0.f, 0.f};
    bf16x8 At[4][2], B0[2][2], B1[2][2];
    const char* cA = (const char*)g.A + (size_t)cur.pm * tstep; const char* cB = (const char*)g.Bt + (size_t)cur.pn * tstep;
    S.a_ready(cur);
    PG8_STAGE(PG8_SB(0, 0), cB, voffB); PG8_STAGE(PG8_SA(0, 0), cA, voffA); PG8_STAGE(PG8_SB(0, 1), cB + hstep, voffB); PG8_STAGE(PG8_SA(0, 1), cA + hstep, voffA);
    if (wr == 1) PG8_BAR;
    PG8_WAIT_V(4); PG8_BAR;
    PG8_STAGE(PG8_SB(1, 0), cB + kstep, voffB); PG8_STAGE(PG8_SA(1, 0), cA + kstep, voffA); PG8_STAGE(PG8_SB(1, 1), cB + hstep + kstep, voffB);
    PG8_WAIT_V(6); PG8_BAR;
    PG8_STAMP();
    for (;;) {
        const bool has_next = S.next(ui + 1, nxt);
        const char* nA = has_next ? (const char*)g.A + (size_t)nxt.pm * tstep : cA; const char* nB = has_next ? (const char*)g.Bt + (size_t)nxt.pn * tstep : cB;
        for (int t = 0; t < nt; t += 2) {
            const bool last = (t == nt - 2);
            const char* a1 = cA + (size_t)(t + 1) * kstep;
            const char* a2 = last ? nA : cA + (size_t)(t + 2) * kstep; const char* b2 = last ? nB : cB + (size_t)(t + 2) * kstep;
            const char* a3 = a2 + kstep; const char* b3 = b2 + kstep;
            if (last && has_next) S.a_ready(nxt);
            PG8_LDB(B0, 0, 0); PG8_SCHED; PG8_LDA(At, 0, 0); PG8_STAGE(PG8_SA(1, 1), a1 + hstep, voffA);
            PG8_WAIT_L(8); PG8_BAR; PG8_WAIT_L(0); PG8_MMA(0, 0, At, B0); PG8_BAR; PG8_SCHED;
            PG8_LDB(B1, 0, 1); PG8_STAGE(PG8_SB(0, 0), b2, voffB);
            PG8_BAR; PG8_WAIT_L(0); PG8_MMA(0, 1, At, B1); PG8_BAR;
            PG8_LDA(At, 0, 1); PG8_STAGE(PG8_SA(0, 0), a2, voffA);
            PG8_BAR; PG8_WAIT_L(0); PG8_MMA(1, 0, At, B0); PG8_BAR; PG8_SCHED;
            PG8_STAGE(PG8_SB(0, 1), b2 + hstep, voffB);
            PG8_WAIT_V(6); PG8_BAR; PG8_MMA(1, 1, At, B1); PG8_BAR;
            PG8_LDB(B0, 1, 0); PG8_SCHED; PG8_LDA(At, 1, 0); PG8_STAGE(PG8_SA(0, 1), a2 + hstep, voffA);
            PG8_WAIT_L(8); PG8_BAR; PG8_WAIT_L(0); PG8_MMA(0, 0, At, B0); PG8_BAR; PG8_SCHED;
            PG8_LDB(B1, 1, 1); PG8_STAGE(PG8_SB(1, 0), b3, voffB);
            PG8_BAR; PG8_WAIT_L(0); PG8_MMA(0, 1, At, B1); PG8_BAR;
            PG8_LDA(At, 1, 1); PG8_STAGE(PG8_SA(1, 0), a3, voffA);
            PG8_BAR; PG8_WAIT_L(0); PG8_MMA(1, 0, At, B0); PG8_BAR; PG8_SCHED;
            PG8_STAGE(PG8_SB(1, 1), b3 + hstep, voffB);
            PG8_WAIT_V(6); PG8_BAR; PG8_MMA(1, 1, At, B1); PG8_BAR;
        }
        PG8_STAMP();
        if constexpr (!Epi::AFTER_DRAIN) { E(acc, cur, wr, wc, fr, fq); S.done(cur); }
        PG8_STAMP();
        if (!has_next) break;
#pragma unroll
        for (int a = 0; a < 2; ++a)
#pragma unroll
            for (int b = 0; b < 2; ++b)
#pragma unroll
                for (int m = 0; m < 4; ++m)
#pragma unroll
                    for (int n = 0; n < 2; ++n) acc[a][b][m][n] = (f32x4){0.f, 0.f, 0.f, 0.f};
        cur = nxt; cA = nA; cB = nB; ++ui;
    }
    PG8_WAIT_V(0);
    if (wr == 0) PG8_BAR;
    PG8_BAR;
    if constexpr (Epi::AFTER_DRAIN) { E.fused(acc, cur, wr, wc, fr, fq, lds, wid, lane); S.done(cur); }
    PG8_STAMP();
    if (STAMP && wid == 0) { stamps[lane] = lane < nts ? (((unsigned long long)(unsigned)ts_hi << 32) | (unsigned)ts_lo) : 0ull;
        if (lane == 62) stamps[62] = rt_entry; if (lane == 63) stamps[63] = (unsigned long long)wall_clock64(); }
#undef PG8_STAMP
#undef PG8_SA
#undef PG8_SB
#undef PG8_STAGE
#undef PG8_LDA
#undef PG8_LDB
#undef PG8_MMA
#undef PG8_WAIT_V
#undef PG8_WAIT_L
#undef PG8_BAR
#undef PG8_SCHED
}
}

#define LAS __attribute__((address_space(3)))
typedef unsigned short bf16_t;
typedef pg8::bf16x8 bf16x8;
typedef pg8::f32x4 f32x4;
typedef unsigned u32x2 __attribute__((ext_vector_type(2)));
typedef unsigned u32x4 __attribute__((ext_vector_type(4)));

constexpr int NB = 8, SEQ = 2048, DM = 1024, T = NB * SEQ, FF = 2816, NUP = 2 * FF, NIN = 3840, DIN = 3784;
constexpr float EPS = 1e-6f;
constexpr int LDS_BYTES = 147456;
constexpr int SCS = 2064;
constexpr int MASK_OFF = 16 * SCS * 4;

constexpr size_t OFF_W13A = 0;
constexpr size_t OFF_W2A  = OFF_W13A + (size_t)NUP * DM * 2;
constexpr size_t OFF_WIN  = OFF_W2A + (size_t)DM * FF * 2;
constexpr size_t OFF_WPOOL = OFF_WIN + (size_t)NIN * DM * 2;
constexpr size_t OFF_WPA  = OFF_WPOOL + (size_t)512 * 512 * 2;
constexpr size_t OFF_WPP  = OFF_WPA + (size_t)DM * 512 * 2;
constexpr size_t OFF_WOUT = OFF_WPP + (size_t)DM * 512 * 2;
constexpr size_t OFF_W13B = OFF_WOUT + (size_t)DM * DM * 2;
constexpr size_t OFF_W2B  = OFF_W13B + (size_t)NUP * DM * 2;
constexpr size_t OFF_ROPE = OFF_W2B + (size_t)DM * FF * 2;
constexpr size_t OFF_SS   = OFF_ROPE + (size_t)T * 32 * 4 * 2;
constexpr size_t OFF_AB0  = OFF_SS + (size_t)T * 16 * 4;
constexpr size_t OFF_AB1  = OFF_AB0 + (size_t)T * DM * 2;
constexpr size_t OFF_R    = OFF_AB1 + (size_t)T * DM * 2;
constexpr size_t OFF_SGA  = OFF_R;
constexpr size_t OFF_SGP  = OFF_SGA + (size_t)T * DM * 2;
constexpr size_t OFF_Q    = OFF_SGP + (size_t)T * DM * 2;
constexpr size_t OFF_QI   = OFF_Q + (size_t)T * 512 * 2;
constexpr size_t OFF_U    = OFF_QI + (size_t)T * 512 * 2;
constexpr size_t OFF_K    = OFF_U + (size_t)T * 512 * 4;
constexpr size_t OFF_KI   = OFF_K + (size_t)T * 64 * 2;
constexpr size_t OFF_VT   = OFF_KI + (size_t)T * 64 * 2;
constexpr size_t OFF_WI   = OFF_VT + (size_t)T * 64 * 2;
constexpr size_t WS_END   = OFF_WI + (size_t)T * 8 * 4;
constexpr size_t OFF_G    = OFF_R;
constexpr size_t OFF_M1   = OFF_Q;
static_assert(OFF_G + (size_t)T * FF * 2 <= WS_END && OFF_M1 + (size_t)T * DM * 4 <= OFF_K, "overlay map");

__constant__ float INV_FREQ[32] = {1.000000000e+00f, 7.498942614e-01f, 5.623413324e-01f, 4.216965139e-01f, 3.162277639e-01f, 2.371373773e-01f, 1.778279394e-01f, 1.333521307e-01f, 1.000000015e-01f, 7.498941571e-02f, 5.623413250e-02f, 4.216965288e-02f, 3.162277490e-02f, 2.371373773e-02f, 1.778279431e-02f, 1.333521493e-02f, 9.999999776e-03f, 7.498941850e-03f, 5.623413250e-03f, 4.216964822e-03f, 3.162277630e-03f, 2.371373586e-03f, 1.778279431e-03f, 1.333521446e-03f, 1.000000047e-03f, 7.498942432e-04f, 5.623413017e-04f, 4.216965172e-04f, 3.162277571e-04f, 2.371373703e-04f, 1.778279402e-04f, 1.333521504e-04f};

__device__ __forceinline__ float bf_lo(unsigned w) { return __uint_as_float(w << 16); }
__device__ __forceinline__ float bf_hi(unsigned w) { return __uint_as_float(w & 0xffff0000u); }
__device__ __forceinline__ u32x2 pack4(f32x4 v) { u32x2 w; w.x = pg8::cvt_pk_bf16(v[0], v[1]); w.y = pg8::cvt_pk_bf16(v[2], v[3]); return w; }
__device__ __forceinline__ float sum4(f32x4 v) { return (v[0] + v[1]) + (v[2] + v[3]); }
__device__ __forceinline__ float sigmoidf_(float x) { return __builtin_amdgcn_rcpf(1.0f + __builtin_amdgcn_exp2f(-1.44269504f * x)); }
__device__ __forceinline__ float wave_sum(float v) {
#pragma unroll
    for (int o = 1; o < 64; o <<= 1) v += __shfl_xor(v, o);
    return v;
}
__device__ __forceinline__ float row_rinv(const float* ss, int r) {
    const f32x4* p = (const f32x4*)(ss + (size_t)r * 16);
    const f32x4 a = p[0], b = p[1], c = p[2], d = p[3];
    const float s = (sum4(a) + sum4(b)) + (sum4(c) + sum4(d));
    return 1.0f / sqrtf(s * (1.0f / DM) + EPS);
}

enum { CV_NAT = 0, CV_UP = 1, CV_IN = 2, CV_POOL = 3 };
template <int MODE>
__device__ __forceinline__ void cvt_item(const float* s0, const float* s1, int K, int nblk, bf16_t* WT, LAS float* scr, int item, int lane) {
    const int kb = item / nblk, nb = item % nblk, k0 = 64 * kb, R = 32 * nb + (lane & 31);
    const float* p = s0; int ld = nblk * 32, col = R, ks0 = k0; bool valid = true;
    if (MODE == CV_UP) { const int grp = R >> 5, n = (R >> 4) & 1, jj = R & 15; p = n ? s1 : s0; ld = FF; col = 16 * grp + jj; }
    if (MODE == CV_IN) {
        const int pn = R >> 8, rem = R & 255, bj = rem >> 7, wc = (rem >> 5) & 3, j = rem & 31; ld = DIN;
        if (pn < 2) col = 64 * (4 * pn + wc) + 32 * bj + j;
        else if (pn == 2) {
            if (wc == 0) col = 512 + 32 * bj + j; else if (wc == 1) col = 1152 + 32 * bj + j; else if (wc == 2) col = 576 + 32 * bj + j;
            else { col = 1216 + (j & 7); valid = (bj == 0 && j < 8); }
        }
        else if (pn < 5) col = 640 + 64 * (4 * (pn - 3) + wc) + 32 * bj + j;
        else if (pn < 7) col = 1224 + 256 * (pn - 5) + rem;
        else if (pn < 11) col = 1736 + 256 * (pn - 7) + rem;
        else col = 2760 + 256 * (pn - 11) + rem;
    }
    if (MODE == CV_POOL) { const int g = R >> 7; p = s0 + g * 16384; ld = 128; col = R & 127; valid = ((k0 >> 7) == g); ks0 = k0 & 127; }
#pragma unroll 8
    for (int i = 0; i < 32; ++i) { const int kk = 2 * i + (lane >> 5); scr[kk * 33 + (lane & 31)] = valid ? p[(size_t)(ks0 + kk) * ld + col] : 0.f; }
    asm volatile("s_waitcnt lgkmcnt(0)" ::: "memory");
    const int c = lane & 7;
#pragma unroll
    for (int j = 0; j < 4; ++j) { const int n = (lane >> 3) + 8 * j; const LAS float* s = scr + (8 * c) * 33 + n;
        u32x4 o; o.x = pg8::cvt_pk_bf16(s[0 * 33], s[1 * 33]); o.y = pg8::cvt_pk_bf16(s[2 * 33], s[3 * 33]); o.z = pg8::cvt_pk_bf16(s[4 * 33], s[5 * 33]); o.w = pg8::cvt_pk_bf16(s[6 * 33], s[7 * 33]);
        *(u32x4*)(WT + (size_t)(32 * nb + n) * K + k0 + 8 * c) = o; }
    asm volatile("s_waitcnt lgkmcnt(0)" ::: "memory");
}

struct EpiUp {
    static constexpr bool PERM = false, AFTER_DRAIN = false;
    bf16_t* G; const float* ss;
    __device__ __forceinline__ void operator()(const f32x4 (&acc)[2][2][4][2], const pg8::Unit& u, int wr, int wc, int fr, int fq) const {
#pragma unroll
        for (int ai = 0; ai < 2; ++ai)
#pragma unroll
            for (int m = 0; m < 4; ++m) {
                const int r = u.pm * 256 + ai * 128 + wr * 64 + m * 16 + fr;
                const float rs = ss ? row_rinv(ss, r) : 1.0f;
#pragma unroll
                for (int bj = 0; bj < 2; ++bj) {
                    const f32x4 a = acc[ai][bj][m][0] * rs, b = acc[ai][bj][m][1] * rs; f32x4 g;
#pragma unroll
                    for (int e = 0; e < 4; ++e) g[e] = a[e] * sigmoidf_(a[e]) * b[e];
                    *(u32x2*)(G + (size_t)r * FF + u.pn * 128 + bj * 64 + wc * 16 + 4 * fq) = pack4(g);
                }
            }
    }
};
struct EpiRes {
    static constexpr bool PERM = false, AFTER_DRAIN = false;
    const float* res; float* out; float alpha; const float* gnext; bf16_t* anext; float* ss;
    __device__ __forceinline__ void operator()(const f32x4 (&acc)[2][2][4][2], const pg8::Unit& u, int wr, int wc, int fr, int fq) const {
#pragma unroll
        for (int ai = 0; ai < 2; ++ai)
#pragma unroll
            for (int m = 0; m < 4; ++m) {
                const int r = u.pm * 256 + ai * 128 + wr * 64 + m * 16 + fr; float sq = 0.f;
#pragma unroll
                for (int bj = 0; bj < 2; ++bj)
#pragma unroll
                    for (int n = 0; n < 2; ++n) {
                        const int c = u.pn * 256 + bj * 128 + wc * 32 + n * 16 + 4 * fq; const size_t off = (size_t)r * DM + c;
                        const f32x4 o = *(const f32x4*)(res + off) + acc[ai][bj][m][n] * alpha;
                        *(f32x4*)(out + off) = o;
                        if (gnext) { sq += (o[0] * o[0] + o[1] * o[1]) + (o[2] * o[2] + o[3] * o[3]); const f32x4 gv = *(const f32x4*)(gnext + c); *(u32x2*)(anext + off) = pack4(o * gv); }
                    }
                if (gnext) { sq += __shfl_xor(sq, 16); sq += __shfl_xor(sq, 32); if (fq == 0) ss[(size_t)r * 16 + u.pn * 4 + wc] = sq; }
            }
    }
};
struct EpiIn {
    static constexpr bool PERM = false, AFTER_DRAIN = false;
    const float* ss; const float* cs; const float* sn; const float* qn; const float* kn;
    bf16_t *Q, *QI, *K, *KI, *VT; float *WI, *U; bf16_t *SGA, *SGP;
    __device__ __forceinline__ void operator()(const f32x4 (&acc)[2][2][4][2], const pg8::Unit& u, int wr, int wc, int fr, int fq) const {
        const int pn = u.pn;
#pragma unroll
        for (int ai = 0; ai < 2; ++ai)
#pragma unroll
            for (int m = 0; m < 4; ++m) {
                const int r = u.pm * 256 + ai * 128 + wr * 64 + m * 16 + fr;
                const float rs = row_rinv(ss, r);
                f32x4 v[2][2];
#pragma unroll
                for (int bj = 0; bj < 2; ++bj)
#pragma unroll
                    for (int n = 0; n < 2; ++n) v[bj][n] = acc[ai][bj][m][n] * rs;
                if (pn < 5) {
                    const bool is_q = pn < 2, is_misc = pn == 2;
                    const bool do_norm = is_q || (is_misc && wc == 0), do_rope = !(is_misc && wc >= 2);
                    if (do_norm) {
                        float sq = 0.f;
#pragma unroll
                        for (int bj = 0; bj < 2; ++bj)
#pragma unroll
                            for (int n = 0; n < 2; ++n) sq += (v[bj][n][0] * v[bj][n][0] + v[bj][n][1] * v[bj][n][1]) + (v[bj][n][2] * v[bj][n][2] + v[bj][n][3] * v[bj][n][3]);
                        sq += __shfl_xor(sq, 16); sq += __shfl_xor(sq, 32);
                        const float rn = 1.0f / sqrtf(sq * (1.0f / 64.0f) + EPS);
                        const float* gp = is_q ? qn : kn;
#pragma unroll
                        for (int bj = 0; bj < 2; ++bj)
#pragma unroll
                            for (int n = 0; n < 2; ++n) v[bj][n] = v[bj][n] * rn * *(const f32x4*)(gp + 32 * bj + 16 * n + 4 * fq);
                    }
                    if (do_rope) {
#pragma unroll
                        for (int n = 0; n < 2; ++n) {
                            const f32x4 c4 = *(const f32x4*)(cs + (size_t)r * 32 + 16 * n + 4 * fq), s4 = *(const f32x4*)(sn + (size_t)r * 32 + 16 * n + 4 * fq);
                            const f32x4 x1 = v[0][n], x2 = v[1][n];
                            v[0][n] = x1 * c4 - x2 * s4; v[1][n] = x2 * c4 + x1 * s4;
                        }
                    }
                    if (is_misc && wc == 2) {
                        const int b = r / SEQ, s = r % SEQ;
#pragma unroll
                        for (int bj = 0; bj < 2; ++bj)
#pragma unroll
                            for (int n = 0; n < 2; ++n)
#pragma unroll
                                for (int e = 0; e < 4; ++e) { const int d = 32 * bj + 16 * n + 4 * fq + e; VT[((size_t)b * 64 + d) * SEQ + s] = (bf16_t)(pg8::cvt_pk_bf16(v[bj][n][e], 0.f) & 0xffffu); }
                    } else if (is_misc && wc == 3) {
                        if (fq < 2) *(f32x4*)(WI + (size_t)r * 8 + 4 * fq) = v[0][0];
                    } else {
                        bf16_t* dst;
                        if (is_q) dst = Q + ((size_t)r * 8 + 4 * pn + wc) * 64;
                        else if (is_misc) dst = (wc == 0 ? K : KI) + (size_t)r * 64;
                        else dst = QI + ((size_t)r * 8 + 4 * (pn - 3) + wc) * 64;
#pragma unroll
                        for (int bj = 0; bj < 2; ++bj)
#pragma unroll
                            for (int n = 0; n < 2; ++n) *(u32x2*)(dst + 32 * bj + 16 * n + 4 * fq) = pack4(v[bj][n]);
                    }
                } else if (pn < 7) {
#pragma unroll
                    for (int bj = 0; bj < 2; ++bj)
#pragma unroll
                        for (int n = 0; n < 2; ++n) *(f32x4*)(U + (size_t)r * 512 + 256 * (pn - 5) + 128 * bj + 32 * wc + 16 * n + 4 * fq) = v[bj][n];
                } else {
                    bf16_t* dst = (pn < 11) ? SGA + (size_t)r * DM + 256 * (pn - 7) : SGP + (size_t)r * DM + 256 * (pn - 11);
#pragma unroll
                    for (int bj = 0; bj < 2; ++bj)
#pragma unroll
                        for (int n = 0; n < 2; ++n) { f32x4 g;
#pragma unroll
                            for (int e = 0; e < 4; ++e) g[e] = sigmoidf_(v[bj][n][e]);
                            *(u32x2*)(dst + 128 * bj + 32 * wc + 16 * n + 4 * fq) = pack4(g); }
                }
            }
    }
};
struct EpiPool {
    static constexpr bool PERM = false, AFTER_DRAIN = false;
    const float* pb; const float* psc; bf16_t* Y; int ldo;
    __device__ __forceinline__ void operator()(const f32x4 (&acc)[2][2][4][2], const pg8::Unit& u, int wr, int wc, int fr, int fq) const {
#pragma unroll
        for (int bj = 0; bj < 2; ++bj)
#pragma unroll
            for (int n = 0; n < 2; ++n) {
                const int c = u.pn * 256 + bj * 128 + wc * 32 + n * 16 + 4 * fq;
                const f32x4 bv = *(const f32x4*)(pb + c), sv = *(const f32x4*)(psc + c);
#pragma unroll
                for (int ai = 0; ai < 2; ++ai)
#pragma unroll
                    for (int m = 0; m < 4; ++m) { const int r = u.pm * 256 + ai * 128 + wr * 64 + m * 16 + fr; *(u32x2*)(Y + (size_t)r * ldo + c) = pack4((acc[ai][bj][m][n] + bv) * sv); }
            }
    }
};
template <int STEP> struct EpiProj {
    static constexpr bool PERM = false, AFTER_DRAIN = false;
    const bf16_t* SG; float* M1; bf16_t* MG;
    __device__ __forceinline__ void operator()(const f32x4 (&acc)[2][2][4][2], const pg8::Unit& u, int wr, int wc, int fr, int fq) const {
#pragma unroll
        for (int ai = 0; ai < 2; ++ai)
#pragma unroll
            for (int m = 0; m < 4; ++m) {
                const int r = u.pm * 256 + ai * 128 + wr * 64 + m * 16 + fr;
#pragma unroll
                for (int bj = 0; bj < 2; ++bj)
#pragma unroll
                    for (int n = 0; n < 2; ++n) {
                        const size_t off = (size_t)r * DM + u.pn * 256 + bj * 128 + wc * 32 + n * 16 + 4 * fq;
                        const u32x2 gw = *(const u32x2*)(SG + off);
                        const f32x4 g = {bf_lo(gw.x), bf_hi(gw.x), bf_lo(gw.y), bf_hi(gw.y)};
                        if (STEP == 0) *(f32x4*)(M1 + off) = g * acc[ai][bj][m][n];
                        else *(u32x2*)(MG + off) = pack4(*(const f32x4*)(M1 + off) + g * acc[ai][bj][m][n]);
                    }
            }
    }
};

__device__ __forceinline__ unsigned ord_key(float v) { const unsigned b = __float_as_uint(v); return (b & 0x80000000u) ? ~b : (b | 0x80000000u); }

__device__ __forceinline__ void select_row(const LAS float* srow, int t, LAS unsigned* mrow, int lane) {
    if (t + 1 <= 256) {
        const int lo = 32 * lane; unsigned w;
        if (lo + 31 <= t) w = 0xffffffffu; else if (lo > t) w = 0u; else w = (1u << (t - lo + 1)) - 1u;
        mrow[lane] = w; return;
    }
    const int nreg = (t >> 6) + 1;
    unsigned ku[32];
#pragma unroll
    for (int i = 0; i < 32; ++i) { const int key = 64 * i + lane; float v = -__builtin_inff(); if (i < nreg) { const float sv = srow[key]; v = (key <= t) ? sv : v; } ku[i] = ord_key(v); }
    unsigned lo = 0u, hi = 0xffffffffu; int chi = 0; bool exact = false;
    while (hi - lo > 1u) {
        const unsigned mid = lo + ((hi - lo) >> 1); int c = 0;
#pragma unroll
        for (int i = 0; i < 32; ++i) if (i < nreg) c += __popcll(__ballot(ku[i] > mid));
        if (c == 256) { hi = mid; chi = c; exact = true; break; }
        if (c > 256) lo = mid; else { hi = mid; chi = c; }
    }
    int need = exact ? 0 : (256 - chi);
    unsigned outw = 0u;
#pragma unroll
    for (int i = 0; i < 32; ++i) {
        unsigned long long sel = 0ull;
        if (i < nreg) {
            sel = __ballot(ku[i] > hi);
            if (need > 0) {
                unsigned long long eq = __ballot(ku[i] == hi); int cnt = __popcll(eq);
                while (cnt > need) { eq &= ~(1ull << (63 - __builtin_clzll(eq))); --cnt; }
                need -= cnt; sel |= eq;
            }
        }
        if (lane == 2 * i) outw = (unsigned)sel;
        if (lane == 2 * i + 1) outw = (unsigned)(sel >> 32);
    }
    mrow[lane] = outw;
}

struct P4Ptrs { const bf16_t *Q, *QI, *K, *KI, *VT; const float* WI; bf16_t* Y; };

__device__ __forceinline__ void p4_unit(LAS unsigned char* lds, const P4Ptrs& P, int b, int q0, int wid, int lane) {
    LAS float* sc = (LAS float*)lds; LAS unsigned* mk = (LAS unsigned*)(lds + MASK_OFF);
    const int lg = lane >> 4, ln = lane & 15; const size_t tb = (size_t)b * SEQ;
    {
        bf16x8 aX[4][2], aY[4][2]; float w[4][8];
        const float idx_scale = 0.125f * 0.35355339059327373f;
#pragma unroll
        for (int g = 0; g < 4; ++g) {
            const bf16_t* pq = P.QI + ((tb + q0 + 4 * g + (ln >> 2)) * 8 + (ln & 3)) * 64 + 8 * lg;
#pragma unroll
            for (int ks = 0; ks < 2; ++ks) { aX[g][ks] = *(const bf16x8*)(pq + 32 * ks); aY[g][ks] = *(const bf16x8*)(pq + 256 + 32 * ks); }
            const f32x4* pw = (const f32x4*)(P.WI + (tb + q0 + 4 * g + lg) * 8); const f32x4 w0 = pw[0], w1 = pw[1];
#pragma unroll
            for (int e = 0; e < 4; ++e) { w[g][e] = w0[e] * idx_scale; w[g][4 + e] = w1[e] * idx_scale; }
        }
        const int ntile = q0 / 16 + 1;
        for (int kt = wid; kt < ntile; kt += 8) {
            const bf16_t* pk = P.KI + (tb + 16 * kt + ln) * 64 + 8 * lg;
            const bf16x8 b0 = *(const bf16x8*)pk, b1 = *(const bf16x8*)(pk + 32);
#pragma unroll
            for (int g = 0; g < 4; ++g) {
                f32x4 x = {0.f, 0.f, 0.f, 0.f}, y = {0.f, 0.f, 0.f, 0.f};
                x = __builtin_amdgcn_mfma_f32_16x16x32_bf16(aX[g][0], b0, x, 0, 0, 0); x = __builtin_amdgcn_mfma_f32_16x16x32_bf16(aX[g][1], b1, x, 0, 0, 0);
                y = __builtin_amdgcn_mfma_f32_16x16x32_bf16(aY[g][0], b0, y, 0, 0, 0); y = __builtin_amdgcn_mfma_f32_16x16x32_bf16(aY[g][1], b1, y, 0, 0, 0);
                float s = 0.f;
#pragma unroll
                for (int e = 0; e < 4; ++e) { s += w[g][e] * fmaxf(x[e], 0.f); s += w[g][4 + e] * fmaxf(y[e], 0.f); }
                sc[(4 * g + lg) * SCS + 16 * kt + ln] = s;
            }
        }
    }
    __syncthreads();
    select_row(sc + (2 * wid) * SCS, q0 + 2 * wid, mk + (2 * wid) * 64, lane);
    select_row(sc + (2 * wid + 1) * SCS, q0 + 2 * wid + 1, mk + (2 * wid + 1) * 64, lane);
    __syncthreads();
    {
        const bf16_t* pq = P.Q + ((tb + q0 + ln) * 8 + wid) * 64 + 8 * lg;
        const bf16x8 qb0 = *(const bf16x8*)pq, qb1 = *(const bf16x8*)(pq + 32);
        f32x4 o[4];
#pragma unroll
        for (int dt = 0; dt < 4; ++dt) o[dt] = (f32x4){0.f, 0.f, 0.f, 0.f};
        float mrun = -1e30f, lsum = 0.f;
        const float cl = 0.125f * 1.44269504f;
        const int nstep = (q0 + 16 + 31) / 32;
        for (int st = 0; st < nstep; ++st) {
            const int kb = 32 * st;
            const bf16_t* pk = P.K + (tb + kb + ln) * 64 + 8 * lg;
            const bf16x8 ka0 = *(const bf16x8*)pk, ka1 = *(const bf16x8*)(pk + 32), kc0 = *(const bf16x8*)(pk + 1024), kc1 = *(const bf16x8*)(pk + 1024 + 32);
            f32x4 sa = {0.f, 0.f, 0.f, 0.f}, sb = {0.f, 0.f, 0.f, 0.f};
            sa = __builtin_amdgcn_mfma_f32_16x16x32_bf16(ka0, qb0, sa, 0, 0, 0); sa = __builtin_amdgcn_mfma_f32_16x16x32_bf16(ka1, qb1, sa, 0, 0, 0);
            sb = __builtin_amdgcn_mfma_f32_16x16x32_bf16(kc0, qb0, sb, 0, 0, 0); sb = __builtin_amdgcn_mfma_f32_16x16x32_bf16(kc1, qb1, sb, 0, 0, 0);
            const unsigned mw = mk[ln * 64 + st] >> (4 * lg);
            float mx = fmaxf(fmaxf(fmaxf(sa[0], sa[1]), fmaxf(sa[2], sa[3])), fmaxf(fmaxf(sb[0], sb[1]), fmaxf(sb[2], sb[3])));
            mx = fmaxf(mx, __shfl_xor(mx, 16)); mx = fmaxf(mx, __shfl_xor(mx, 32));
            const float mnew = fmaxf(mrun, mx * cl);
            const float alpha = __builtin_amdgcn_exp2f(mrun - mnew); mrun = mnew;
            float pa[4], pb[4], ps = 0.f;
#pragma unroll
            for (int e = 0; e < 4; ++e) {
                pa[e] = ((mw >> e) & 1u) ? __builtin_amdgcn_exp2f(sa[e] * cl - mnew) : 0.f;
                pb[e] = ((mw >> (16 + e)) & 1u) ? __builtin_amdgcn_exp2f(sb[e] * cl - mnew) : 0.f;
                ps += pa[e] + pb[e];
            }
            lsum = lsum * alpha + ps;
            union { u32x4 u; bf16x8 v; } pk8;
            pk8.u.x = pg8::cvt_pk_bf16(pa[0], pa[1]); pk8.u.y = pg8::cvt_pk_bf16(pa[2], pa[3]); pk8.u.z = pg8::cvt_pk_bf16(pb[0], pb[1]); pk8.u.w = pg8::cvt_pk_bf16(pb[2], pb[3]);
#pragma unroll
            for (int dt = 0; dt < 4; ++dt) {
                const bf16_t* pv = P.VT + ((size_t)b * 64 + 16 * dt + ln) * SEQ + kb + 4 * lg;
                union { u32x4 u; bf16x8 v; } va; const u32x2 v0 = *(const u32x2*)pv, v1 = *(const u32x2*)(pv + 16);
                va.u.x = v0.x; va.u.y = v0.y; va.u.z = v1.x; va.u.w = v1.y;
                o[dt] = __builtin_amdgcn_mfma_f32_16x16x32_bf16(va.v, pk8.v, o[dt] * alpha, 0, 0, 0);
            }
        }
        lsum += __shfl_xor(lsum, 16); lsum += __shfl_xor(lsum, 32);
        const float inv = 1.0f / lsum;
        bf16_t* py = P.Y + (tb + q0 + ln) * 512 + wid * 64 + 4 * lg;
#pragma unroll
        for (int dt = 0; dt < 4; ++dt) *(u32x2*)(py + 16 * dt) = pack4(o[dt] * inv);
    }
    __syncthreads();
}

struct Args { const void* in[20]; float* out; unsigned char* ws; int ph_lo, ph_hi; };
#ifndef MK_N_LAUNCHES
#define MK_N_LAUNCHES 1
#endif
constexpr int NPHASE = 10;

__global__ void __launch_bounds__(512) fwd_kernel(Args a) {
    extern __shared__ __attribute__((aligned(16))) unsigned char lds_raw[];
    LAS unsigned char* lds = (LAS unsigned char*)lds_raw;
    const int tid = threadIdx.x, lane = tid & 63, wid = __builtin_amdgcn_readfirstlane(tid >> 6);
    const int G = gridDim.x, bx = blockIdx.x;
    const int lo = a.ph_lo, hi = a.ph_hi;
    unsigned char* ws = a.ws;
    const float* x = (const float*)a.in[0]; const int* positions = (const int*)a.in[1];
    float* out = a.out;
    bf16_t* W13A = (bf16_t*)(ws + OFF_W13A); bf16_t* W2A = (bf16_t*)(ws + OFF_W2A); bf16_t* WIN = (bf16_t*)(ws + OFF_WIN); bf16_t* WPOOL = (bf16_t*)(ws + OFF_WPOOL);
    bf16_t* WPA = (bf16_t*)(ws + OFF_WPA); bf16_t* WPP = (bf16_t*)(ws + OFF_WPP); bf16_t* WOUT = (bf16_t*)(ws + OFF_WOUT); bf16_t* W13B = (bf16_t*)(ws + OFF_W13B); bf16_t* W2B = (bf16_t*)(ws + OFF_W2B);
    float* CS = (float*)(ws + OFF_ROPE); float* SN = CS + (size_t)T * 32; float* SS = (float*)(ws + OFF_SS);
    bf16_t* AB0 = (bf16_t*)(ws + OFF_AB0); bf16_t* AB1 = (bf16_t*)(ws + OFF_AB1);
    bf16_t* SGA = (bf16_t*)(ws + OFF_SGA); bf16_t* SGP = (bf16_t*)(ws + OFF_SGP); bf16_t* Qb = (bf16_t*)(ws + OFF_Q); bf16_t* QIb = (bf16_t*)(ws + OFF_QI);
    float* Ub = (float*)(ws + OFF_U); bf16_t* Kb = (bf16_t*)(ws + OFF_K); bf16_t* KIb = (bf16_t*)(ws + OFF_KI); bf16_t* VTb = (bf16_t*)(ws + OFF_VT); float* WIb = (float*)(ws + OFF_WI);
    bf16_t* Gb = (bf16_t*)(ws + OFF_G); float* M1 = (float*)(ws + OFF_M1);
#if MK_N_LAUNCHES == 1
    cg::grid_group grid = cg::this_grid();
#define SEAM(k) do { if (lo <= (k) && (k) + 1 < hi) grid.sync(); } while (0)
#else
#define SEAM(k) do { } while (0)
#endif
#define IN(k) (lo <= (k) && (k) < hi)

    if (IN(0)) {
        LAS float* scr = (LAS float*)(lds + wid * 8448);
        const int gw = bx * 8 + wid, NGW = G * 8;
        constexpr int I_UP = (DM / 64) * (NUP / 32), I_DN = (FF / 64) * (DM / 32), I_IN = (DM / 64) * (NIN / 32), I_PL = (512 / 64) * (512 / 32), I_PR = (512 / 64) * (DM / 32), I_OUT = (DM / 64) * (DM / 32);
        constexpr int NITEMS = 2 * I_UP + 2 * I_DN + I_IN + I_PL + 2 * I_PR + I_OUT;
        for (int it = gw; it < NITEMS; it += NGW) {
            int r = it;
            if (r < I_UP) { cvt_item<CV_UP>((const float*)a.in[3], (const float*)a.in[4], DM, NUP / 32, W13A, scr, r, lane); continue; } r -= I_UP;
            if (r < I_UP) { cvt_item<CV_UP>((const float*)a.in[17], (const float*)a.in[18], DM, NUP / 32, W13B, scr, r, lane); continue; } r -= I_UP;
            if (r < I_DN) { cvt_item<CV_NAT>((const float*)a.in[5], nullptr, FF, DM / 32, W2A, scr, r, lane); continue; } r -= I_DN;
            if (r < I_DN) { cvt_item<CV_NAT>((const float*)a.in[19], nullptr, FF, DM / 32, W2B, scr, r, lane); continue; } r -= I_DN;
            if (r < I_IN) { cvt_item<CV_IN>((const float*)a.in[7], nullptr, DM, NIN / 32, WIN, scr, r, lane); continue; } r -= I_IN;
            if (r < I_PL) { cvt_item<CV_POOL>((const float*)a.in[10], nullptr, 512, 512 / 32, WPOOL, scr, r, lane); continue; } r -= I_PL;
            if (r < I_PR) { cvt_item<CV_NAT>((const float*)a.in[13], nullptr, 512, DM / 32, WPA, scr, r, lane); continue; } r -= I_PR;
            if (r < I_PR) { cvt_item<CV_NAT>((const float*)a.in[14], nullptr, 512, DM / 32, WPP, scr, r, lane); continue; } r -= I_PR;
            cvt_item<CV_NAT>((const float*)a.in[15], nullptr, DM, DM / 32, WOUT, scr, r, lane);
        }
        for (int i = bx * 512 + tid; i < T * 32; i += G * 512) {
            const int tok = i >> 5, f = i & 31;
            const float ang = (float)positions[tok] * INV_FREQ[f];
            const double rev = (double)ang * 0.15915494309189535; const float fr = (float)(rev - __builtin_rint(rev));
            CS[i] = __builtin_amdgcn_cosf(fr); SN[i] = __builtin_amdgcn_sinf(fr);
        }
        const float* g1 = (const float*)a.in[2];
        for (int m = gw; m < T; m += NGW) {
            const f32x4* xr = (const f32x4*)(x + (size_t)m * DM) + lane; f32x4 v[4]; float s = 0.f;
#pragma unroll
            for (int j = 0; j < 4; ++j) { v[j] = xr[64 * j]; s += (v[j][0] * v[j][0] + v[j][1] * v[j][1]) + (v[j][2] * v[j][2] + v[j][3] * v[j][3]); }
            const float rinv = 1.0f / sqrtf(wave_sum(s) * (1.0f / DM) + EPS);
#pragma unroll
            for (int j = 0; j < 4; ++j) { const f32x4 gv = *((const f32x4*)g1 + lane + 64 * j); *((u32x2*)(AB0 + (size_t)m * DM) + lane + 64 * j) = pack4(v[j] * rinv * gv); }
        }
        asm volatile("s_waitcnt vmcnt(0) lgkmcnt(0)" ::: "memory");
        __syncthreads();
    }
    SEAM(0);
    if (IN(1)) { pg8::Gemm g{AB0, W13A, T, NUP, DM}; pg8::StaticOrder S; S.init(T, NUP, G, bx); EpiUp E{Gb, nullptr}; pg8::gemm_phase<EpiUp, pg8::StaticOrder>(lds, g, S, E, nullptr); }
    SEAM(1);
    if (IN(2)) { pg8::Gemm g{Gb, W2A, T, DM, FF}; pg8::StaticOrder S; S.init(T, DM, G, bx); EpiRes E{x, out, 0.5f, (const float*)a.in[6], AB0, SS}; pg8::gemm_phase<EpiRes, pg8::StaticOrder>(lds, g, S, E, nullptr); }
    SEAM(2);
    if (IN(3)) { pg8::Gemm g{AB0, WIN, T, NIN, DM}; pg8::StaticOrder S; S.init(T, NIN, G, bx);
        EpiIn E{SS, CS, SN, (const float*)a.in[8], (const float*)a.in[9], Qb, QIb, Kb, KIb, VTb, WIb, Ub, SGA, SGP};
        pg8::gemm_phase<EpiIn, pg8::StaticOrder>(lds, g, S, E, nullptr); }
    SEAM(3);
    if (IN(4)) {
        for (int ch = bx; ch < T / 64; ch += G) {
            const int g = tid >> 7, win = 2 << g;
            for (int rr = 0; rr < 64; ++rr) {
                const int t = ch * 64 + rr, pos = t % SEQ, n = (pos + 1 < win) ? pos + 1 : win;
                const float* up = Ub + (size_t)t * 512 + tid; const float u0 = up[0]; float s = u0;
                for (int j = 1; j < n; ++j) s += up[-(ptrdiff_t)j * 512];
                AB1[(size_t)t * 512 + tid] = (bf16_t)(pg8::cvt_pk_bf16(s / (float)n - u0, 0.f) & 0xffffu);
            }
        }
        const P4Ptrs P{Qb, QIb, Kb, KIb, VTb, WIb, AB0};
        for (int i = 0; ; ++i) {
            const int sidx = i * G + bx; if (sidx >= T / 16) break;
            const int rnd = sidx / 256, j = sidx % 256, s2 = rnd * 256 + ((rnd & 1) ? 255 - j : j);
            p4_unit(lds, P, s2 & 7, (s2 >> 3) * 16, wid, lane);
        }
    }
    SEAM(4);
    if (IN(5)) { pg8::Gemm g{AB1, WPOOL, T, 512, 512}; pg8::StaticOrder S; S.init(T, 512, G, bx); EpiPool E{(const float*)a.in[11], (const float*)a.in[12], AB0 + (size_t)T * 512, 512}; pg8::gemm_phase<EpiPool, pg8::StaticOrder>(lds, g, S, E, nullptr); }
    SEAM(5);
    if (IN(6)) {
        { pg8::Gemm g{AB0, WPA, T, DM, 512}; pg8::StaticOrder S; S.init(T, DM, G, bx); EpiProj<0> E{SGA, M1, AB1}; pg8::gemm_phase<EpiProj<0>, pg8::StaticOrder>(lds, g, S, E, nullptr); }
        { pg8::Gemm g{AB0 + (size_t)T * 512, WPP, T, DM, 512}; pg8::StaticOrder S; S.init(T, DM, G, bx); EpiProj<1> E{SGP, M1, AB1}; pg8::gemm_phase<EpiProj<1>, pg8::StaticOrder>(lds, g, S, E, nullptr); }
    }
    SEAM(6);
    if (IN(7)) { pg8::Gemm g{AB1, WOUT, T, DM, DM}; pg8::StaticOrder S; S.init(T, DM, G, bx); EpiRes E{out, out, 1.0f, (const float*)a.in[16], AB0, SS}; pg8::gemm_phase<EpiRes, pg8::StaticOrder>(lds, g, S, E, nullptr); }
    SEAM(7);
    if (IN(8)) { pg8::Gemm g{AB0, W13B, T, NUP, DM}; pg8::StaticOrder S; S.init(T, NUP, G, bx); EpiUp E{Gb, SS}; pg8::gemm_phase<EpiUp, pg8::StaticOrder>(lds, g, S, E, nullptr); }
    SEAM(8);
    if (IN(9)) { pg8::Gemm g{Gb, W2B, T, DM, FF}; pg8::StaticOrder S; S.init(T, DM, G, bx); EpiRes E{out, out, 0.5f, nullptr, nullptr, nullptr}; pg8::gemm_phase<EpiRes, pg8::StaticOrder>(lds, g, S, E, nullptr); }
#undef IN
#undef SEAM
}

extern "C" void kernel_launch(void* const* d_in, const int* in_sizes, int n_in, void* d_out, int out_size, void* d_ws, size_t ws_size, hipStream_t stream) {
    static int grid = 0;
    if (grid == 0) {
        if (n_in != 20 || out_size != T * DM || ws_size < WS_END) { fprintf(stderr, "kernel_launch: unexpected shapes (n_in %d out %d ws %zu need %zu)\n", n_in, out_size, ws_size, (size_t)WS_END); grid = -1; return; }
        int dev = 0, cus = 0, per_cu = 0;
        (void)hipGetDevice(&dev); (void)hipDeviceGetAttribute(&cus, hipDeviceAttributeMultiprocessorCount, dev);
        if (hipFuncSetAttribute((const void*)fwd_kernel, hipFuncAttributeMaxDynamicSharedMemorySize, LDS_BYTES) != hipSuccess) { fprintf(stderr, "kernel_launch: hipFuncSetAttribute failed\n"); grid = -1; return; }
        if (hipOccupancyMaxActiveBlocksPerMultiprocessor(&per_cu, (const void*)fwd_kernel, 512, LDS_BYTES) != hipSuccess || per_cu < 1) per_cu = 1;
        (void)hipGetLastError();
        grid = cus * 1;
        fprintf(stderr, "kernel_launch: grid %d (per_cu query %d)\n", grid, per_cu);
    }
    if (grid < 0) return;
    Args a{};
    for (int i = 0; i < 20; ++i) a.in[i] = d_in[i];
    a.out = (float*)d_out; a.ws = (unsigned char*)d_ws;
#if MK_N_LAUNCHES == 1
    a.ph_lo = 0; a.ph_hi = NPHASE;
    void* args[] = {&a};
    const hipError_t e = hipLaunchCooperativeKernel((const void*)fwd_kernel, dim3(grid), dim3(512), args, LDS_BYTES, stream);
    if (e != hipSuccess) fprintf(stderr, "kernel_launch: cooperative launch failed: %s\n", hipGetErrorString(e));
#else
    for (int p = 0; p < NPHASE; ++p) { a.ph_lo = p; a.ph_hi = p + 1; hipLaunchKernelGGL(fwd_kernel, dim3(grid), dim3(512), LDS_BYTES, stream, a); }
#endif
}
```

```cpp
#include <hip/hip_runtime.h>
#include <hip/hip_cooperative_groups.h>
#include <cstdio>
namespace cg = cooperative_groups;
namespace pg8 {
#define PG8_LAS __attribute__((address_space(3)))
typedef unsigned short bf16_t;
typedef short bf16x8 __attribute__((ext_vector_type(8)));
typedef float f32x4 __attribute__((ext_vector_type(4)));
typedef unsigned u32x4 __attribute__((ext_vector_type(4)));
constexpr int BM = 256, BK = 64, HALF = 128, HTB = HALF * BK * 2  , STAGE_BYTES = 8 * HTB, NXCD = 8, WGM = 8;

__host__ __device__ __forceinline__ int lds_byte(int r, int c) { const int st = (r >> 4) * 2 + (c >> 5), rr = r & 15, cc = c & 31, ob = rr * 64 + cc * 2; return st * 1024 + (ob ^ (((ob >> 9) & 1) << 5)); }
__host__ __device__ __forceinline__ void stage_rc(int b, int& R, int& C) { const int st = b / 1024, sb = b % 1024, swz = sb ^ (((sb >> 9) & 1) << 5); R = (st >> 1) * 16 + swz / 64; C = (st & 1) * 32 + (swz % 64) / 2; }
__host__ __device__ __forceinline__ int perm32(int rho) { const int n = rho >> 4, i = rho & 15; return 8 * (i >> 2) + 4 * n + (i & 3); }

struct Unit { int pm, pn; };
struct Gemm { const bf16_t* A; const bf16_t* Bt; int M, N, K; };

struct StaticOrder {
    int nM, nN, nwg, G, c;
    __host__ __device__ void init(int M, int N, int G_, int c_) { nM = M / BM; nN = N / BM; nwg = nM * nN; G = G_; c = c_; }
    __host__ __device__ bool next(int i, Unit& u) const {
        const long L = (long)i * G + c; if (L >= nwg) return false;
        int wgid = (int)L; { const int q = nwg / NXCD, r = nwg % NXCD, xcd = wgid % NXCD, off = wgid / NXCD; wgid = (xcd < r ? xcd * (q + 1) : r * (q + 1) + (xcd - r) * q) + off; }
        const int nig = WGM * nN, gid = wgid / nig, fm = gid * WGM, gsz = (nM - fm) < WGM ? (nM - fm) : WGM;
        u.pm = fm + ((wgid % nig) % gsz); u.pn = (wgid % nig) / gsz; return true;
    }
    __device__ __forceinline__ void a_ready(const Unit&) const {}
    __device__ __forceinline__ void done(const Unit&) const {}
};
__device__ __forceinline__ unsigned cvt_pk_bf16(float lo, float hi) { unsigned r; asm volatile("v_cvt_pk_bf16_f32 %0, %1, %2" : "=v"(r) : "v"(lo), "v"(hi)); return r; }
template <class Epi, class Sched, bool STAMP = false>
__device__ __forceinline__ void gemm_phase(PG8_LAS unsigned char* lds, const Gemm g, const Sched& S, const Epi& E, unsigned long long* stamps) {
    const int tid = threadIdx.x, wid = __builtin_amdgcn_readfirstlane(tid >> 6), lane = tid & 63, wr = wid >> 2, wc = wid & 3, fr = lane & 15, fq = lane >> 4;
    const int K = g.K, nt = K / BK;
    int ts_lo = 0, ts_hi = 0, nts = 0; const unsigned long long rt_entry = STAMP ? (unsigned long long)wall_clock64() : 0ull;
#define PG8_STAMP() do { if (STAMP && wid == 0 && nts < 64) { const unsigned long long _c = (unsigned long long)clock64(); \
        ts_lo = (lane == nts) ? (int)(unsigned)_c : ts_lo; ts_hi = (lane == nts) ? (int)(unsigned)(_c >> 32) : ts_hi; ++nts; } } while (0)
    PG8_STAMP();
    unsigned voffA[2], voffB[2];
#pragma unroll
    for (int i = 0; i < 2; ++i) { int R, C; stage_rc(tid * 16 + i * 8192, R, C); const int Rb = Epi::PERM ? ((R & ~31) + perm32(R & 31)) : R;
        voffA[i] = (unsigned)(R * K + C) * 2u; voffB[i] = (unsigned)(Rb * K + C) * 2u; }
    const size_t kstep = (size_t)(BK * 2);
    const size_t hstep = (size_t)HALF * K * 2;
    const size_t tstep = 2 * hstep;
    const unsigned ldsw = (unsigned)wid * 1024u;
    const int aoff = lds_byte(wr * 64 + fr, fq * 8), boff = lds_byte(wc * 32 + fr, fq * 8);
#define PG8_SA(b, h) (((b) * 2 + (h)) * HTB)
#define PG8_SB(b, h) ((4 + (b) * 2 + (h)) * HTB)
#define PG8_STAGE(bufoff, gbase, voff) do { _Pragma("unroll") for (int _i = 0; _i < 2; ++_i) \
        __builtin_amdgcn_global_load_lds((const unsigned*)((const char*)(gbase) + (voff)[_i]), (PG8_LAS unsigned*)(lds + (bufoff) + ldsw + _i * 8192), 16, 0, 0); } while (0)
#define PG8_LDA(dst, b, h) do { _Pragma("unroll") for (int m = 0; m < 4; ++m) _Pragma("unroll") for (int k = 0; k < 2; ++k) dst[m][k] = *(const PG8_LAS bf16x8*)(lds + PG8_SA(b, h) + aoff + m * 2048 + k * 1024); } while (0)
#define PG8_LDB(dst, b, h) do { _Pragma("unroll") for (int n = 0; n < 2; ++n) _Pragma("unroll") for (int k = 0; k < 2; ++k) dst[n][k] = *(const PG8_LAS bf16x8*)(lds + PG8_SB(b, h) + boff + n * 2048 + k * 1024); } while (0)
#define PG8_MMA(ai, bj, At, Bt) do { __builtin_amdgcn_s_setprio(1); _Pragma("unroll") for (int m = 0; m < 4; ++m) _Pragma("unroll") for (int n = 0; n < 2; ++n) _Pragma("unroll") for (int k = 0; k < 2; ++k) \
        acc[ai][bj][m][n] = __builtin_amdgcn_mfma_f32_16x16x32_bf16(Bt[n][k], At[m][k], acc[ai][bj][m][n], 0, 0, 0); __builtin_amdgcn_s_setprio(0); } while (0)
#define PG8_WAIT_V(n) asm volatile("s_waitcnt vmcnt(" #n ")" ::: "memory")
#define PG8_WAIT_L(n) asm volatile("s_waitcnt lgkmcnt(" #n ")" ::: "memory")
#define PG8_BAR __builtin_amdgcn_s_barrier()
#define PG8_SCHED __builtin_amdgcn_sched_barrier(0)
    Unit cur, nxt; int ui = 0;
    if (!S.next(0, cur)) return;
    f32x4 acc[2][2][4][2];
#pragma unroll
    for (int a = 0; a < 2; ++a)
#pragma unroll
        for (int b = 0; b < 2; ++b)
#pragma unroll
            for (int m = 0; m < 4; ++m)
#pragma unroll
                for (int n = 0; n < 2; ++n) acc[a][b][m][n] = (f32x4){0.f, 0.f, 0.f, 0.f};
    bf16x8 At[4][2], B0[2][2], B1[2][2];
    const char* cA = (const char*)g.A + (size_t)cur.pm * tstep; const char* cB = (const char*)g.Bt + (size_t)cur.pn * tstep;
    S.a_ready(cur);
    PG8_STAGE(PG8_SB(0, 0), cB, voffB); PG8_STAGE(PG8_SA(0, 0), cA, voffA); PG8_STAGE(PG8_SB(0, 1), cB + hstep, voffB); PG8_STAGE(PG8_SA(0, 1), cA + hstep, voffA);
    if (wr == 1) PG8_BAR;
    PG8_WAIT_V(4); PG8_BAR;
    PG8_STAGE(PG8_SB(1, 0), cB + kstep, voffB); PG8_STAGE(PG8_SA(1, 0), cA + kstep, voffA); PG8_STAGE(PG8_SB(1, 1), cB + hstep + kstep, voffB);
    PG8_WAIT_V(6); PG8_BAR;
    PG8_STAMP();
    for (;;) {
        const bool has_next = S.next(ui + 1, nxt);
        const char* nA = has_next ? (const char*)g.A + (size_t)nxt.pm * tstep : cA; const char* nB = has_next ? (const char*)g.Bt + (size_t)nxt.pn * tstep : cB;
        for (int t = 0; t < nt; t += 2) {
            const bool last = (t == nt - 2);
            const char* a1 = cA + (size_t)(t + 1) * kstep;
            const char* a2 = last ? nA : cA + (size_t)(t + 2) * kstep; const char* b2 = last ? nB : cB + (size_t)(t + 2) * kstep;
            const char* a3 = a2 + kstep; const char* b3 = b2 + kstep;
            if (last && has_next) S.a_ready(nxt);
            PG8_LDB(B0, 0, 0); PG8_SCHED; PG8_LDA(At, 0, 0); PG8_STAGE(PG8_SA(1, 1), a1 + hstep, voffA);
            PG8_WAIT_L(8); PG8_BAR; PG8_WAIT_L(0); PG8_MMA(0, 0, At, B0); PG8_BAR; PG8_SCHED;
            PG8_LDB(B1, 0, 1); PG8_STAGE(PG8_SB(0, 0), b2, voffB);
            PG8_BAR; PG8_WAIT_L(0); PG8_MMA(0, 1, At, B1); PG8_BAR;
            PG8_LDA(At, 0, 1); PG8_STAGE(PG8_SA(0, 0), a2, voffA);
            PG8_BAR; PG8_WAIT_L(0); PG8_MMA(1, 0, At, B0); PG8_BAR; PG8_SCHED;
            PG8_STAGE(PG8_SB(0, 1), b2 + hstep, voffB);
            PG8_WAIT_V(6); PG8_BAR; PG8_MMA(1, 1, At, B1); PG8_BAR;
            PG8_LDB(B0, 1, 0); PG8_SCHED; PG8_LDA(At, 1, 0); PG8_STAGE(PG8_SA(0, 1), a2 + hstep, voffA);
            PG8_WAIT_L(8); PG8_BAR; PG8_WAIT_L(0); PG8_MMA(0, 0, At, B0); PG8_BAR; PG8_SCHED;
            PG8_LDB(B1, 1, 1); PG8_STAGE(PG8_SB(1, 0), b3, voffB);
            PG8_BAR; PG8_WAIT_L(0); PG8_MMA(0, 1, At, B1); PG8_BAR;
            PG8_LDA(At, 1, 1); PG8_STAGE(PG8_SA(1, 0), a3, voffA);
            PG8_BAR; PG8_WAIT_L(0); PG8_MMA(1, 0, At, B0); PG8_BAR; PG8_SCHED;
            PG8_STAGE(PG8_SB(1, 1), b3 + hstep, voffB);
            PG8_WAIT_V(6); PG8_BAR; PG8_MMA(1, 1, At, B1); PG8_BAR;
        }
        PG8_STAMP();
        if constexpr (!Epi::AFTER_DRAIN) { E(acc, cur, wr, wc, fr, fq); S.done(cur); }
        PG8_STAMP();
        if (!has_next) break;
#pragma unroll
        for (int a = 0; a < 2; ++a)
#pragma unroll
            for (int b = 0; b < 2; ++b)
#pragma unroll
                for (int m = 0; m < 4; ++m)
#pragma unroll
                    for (int n = 0; n < 2; ++n) acc[a][b][m][n] = (f32x4){0.f, 0.f, 0.f, 0.f};
        cur = nxt; cA = nA; cB = nB; ++ui;
    }
    PG8_WAIT_V(0);
    if (wr == 0) PG8_BAR;
    PG8_BAR;
    if constexpr (Epi::AFTER_DRAIN) { E.fused(acc, cur, wr, wc, fr, fq, lds, wid, lane); S.done(cur); }
    PG8_STAMP();
    if (STAMP && wid == 0) { stamps[lane] = lane < nts ? (((unsigned long long)(unsigned)ts_hi << 32) | (unsigned)ts_lo) : 0ull;
        if (lane == 62) stamps[62] = rt_entry; if (lane == 63) stamps[63] = (unsigned long long)wall_clock64(); }
#undef PG8_STAMP
#undef PG8_SA
#undef PG8_SB
#undef PG8_STAGE
#undef PG8_LDA
#undef PG8_LDB
#undef PG8_MMA
#undef PG8_WAIT_V
#undef PG8_WAIT_L
#undef PG8_BAR
#undef PG8_SCHED
}
}

#define LAS __attribute__((address_space(3)))
typedef unsigned short bf16_t;
typedef pg8::bf16x8 bf16x8;
typedef pg8::f32x4 f32x4;
typedef unsigned u32x2 __attribute__((ext_vector_type(2)));
typedef unsigned u32x4 __attribute__((ext_vector_type(4)));

constexpr int NB = 8, SEQ = 2048, DM = 1024, T = NB * SEQ, FF = 2816, NUP = 2 * FF, NIN = 3840, DIN = 3784;
constexpr float EPS = 1e-6f;
constexpr int LDS_BYTES = 155648;
constexpr int SCS = 2064;
constexpr int KT_OFF = 16 * SCS * 4;
constexpr int VT_OFF = KT_OFF + 64 * 144;
static_assert(VT_OFF + 64 * 144 <= LDS_BYTES, "LDS map");

constexpr size_t OFF_W13A = 0;
constexpr size_t OFF_W2A  = OFF_W13A + (size_t)NUP * DM * 2;
constexpr size_t OFF_WIN  = OFF_W2A + (size_t)DM * FF * 2;
constexpr size_t OFF_WPOOL = OFF_WIN + (size_t)NIN * DM * 2;
constexpr size_t OFF_WPA  = OFF_WPOOL + (size_t)512 * 512 * 2;
constexpr size_t OFF_WPP  = OFF_WPA + (size_t)DM * 512 * 2;
constexpr size_t OFF_WOUT = OFF_WPP + (size_t)DM * 512 * 2;
constexpr size_t OFF_W13B = OFF_WOUT + (size_t)DM * DM * 2;
constexpr size_t OFF_W2B  = OFF_W13B + (size_t)NUP * DM * 2;
constexpr size_t OFF_ROPE = OFF_W2B + (size_t)DM * FF * 2;
constexpr size_t OFF_SS   = OFF_ROPE + (size_t)T * 32 * 4 * 2;
constexpr size_t OFF_AB0  = OFF_SS + (size_t)T * 16 * 4;
constexpr size_t OFF_AB1  = OFF_AB0 + (size_t)T * DM * 2;
constexpr size_t OFF_R    = OFF_AB1 + (size_t)T * DM * 2;
constexpr size_t OFF_SGA  = OFF_R;
constexpr size_t OFF_SGP  = OFF_SGA + (size_t)T * DM * 2;
constexpr size_t OFF_Q    = OFF_SGP + (size_t)T * DM * 2;
constexpr size_t OFF_QI   = OFF_Q + (size_t)T * 512 * 2;
constexpr size_t OFF_U    = OFF_QI + (size_t)T * 512 * 2;
constexpr size_t OFF_K    = OFF_U + (size_t)T * 512 * 4;
constexpr size_t OFF_KI   = OFF_K + (size_t)T * 64 * 2;
constexpr size_t OFF_VT   = OFF_KI + (size_t)T * 64 * 2;
constexpr size_t OFF_WI   = OFF_VT + (size_t)T * 64 * 2;
constexpr size_t OFF_BAR  = OFF_WI + (size_t)T * 8 * 4;
constexpr size_t OFF_BIASF = OFF_BAR + 16384;
constexpr size_t OFF_WPPF = OFF_BIASF + 4096;
constexpr size_t WS_END   = OFF_WPPF + (size_t)DM * 512 * 2;
constexpr size_t OFF_G    = OFF_R;
constexpr size_t OFF_M1   = OFF_Q;
static_assert(OFF_G + (size_t)T * FF * 2 <= WS_END && OFF_M1 + (size_t)T * DM * 4 <= OFF_K, "overlay map");

__constant__ float INV_FREQ[32] = {1.000000000e+00f, 7.498942614e-01f, 5.623413324e-01f, 4.216965139e-01f, 3.162277639e-01f, 2.371373773e-01f, 1.778279394e-01f, 1.333521307e-01f, 1.000000015e-01f, 7.498941571e-02f, 5.623413250e-02f, 4.216965288e-02f, 3.162277490e-02f, 2.371373773e-02f, 1.778279431e-02f, 1.333521493e-02f, 9.999999776e-03f, 7.498941850e-03f, 5.623413250e-03f, 4.216964822e-03f, 3.162277630e-03f, 2.371373586e-03f, 1.778279431e-03f, 1.333521446e-03f, 1.000000047e-03f, 7.498942432e-04f, 5.623413017e-04f, 4.216965172e-04f, 3.162277571e-04f, 2.371373703e-04f, 1.778279402e-04f, 1.333521504e-04f};

__device__ __forceinline__ float bf_lo(unsigned w) { return __uint_as_float(w << 16); }
__device__ __forceinline__ float bf_hi(unsigned w) { return __uint_as_float(w & 0xffff0000u); }
__device__ __forceinline__ u32x2 pack4(f32x4 v) { u32x2 w; w.x = pg8::cvt_pk_bf16(v[0], v[1]); w.y = pg8::cvt_pk_bf16(v[2], v[3]); return w; }
__device__ __forceinline__ float sum4(f32x4 v) { return (v[0] + v[1]) + (v[2] + v[3]); }
__device__ __forceinline__ float sigmoidf_(float x) { return __builtin_amdgcn_rcpf(1.0f + __builtin_amdgcn_exp2f(-1.44269504f * x)); }
__device__ __forceinline__ float wave_sum(float v) {
#pragma unroll
    for (int o = 1; o < 64; o <<= 1) v += __shfl_xor(v, o);
    return v;
}
__device__ __forceinline__ void row_rinv8(const float* ss, int row0, int fq, float (&rs)[2][4]) {
    f32x4 part[2][4];
#pragma unroll
    for (int ai = 0; ai < 2; ++ai)
#pragma unroll
        for (int m = 0; m < 4; ++m) part[ai][m] = *(const f32x4*)(ss + (size_t)(row0 + ai * 128 + m * 16) * 16 + 4 * fq);
#pragma unroll
    for (int ai = 0; ai < 2; ++ai)
#pragma unroll
        for (int m = 0; m < 4; ++m) { float s = sum4(part[ai][m]); s += __shfl_xor(s, 16); s += __shfl_xor(s, 32); rs[ai][m] = __builtin_amdgcn_rsqf(s * (1.0f / DM) + EPS); }
}

enum { CV_NAT = 0, CV_UP = 1, CV_IN = 2, CV_POOL = 3 };
template <int MODE>
__device__ __forceinline__ void cvt_item(const float* s0, const float* s1, int K, int nblk, bf16_t* WT, LAS float* scr, int item, int lane, const float* gk = nullptr) {
    const int kb = item / nblk, nb = item % nblk, k0 = 64 * kb, R = 32 * nb + (lane & 31);
    const float* p = s0; int ld = nblk * 32, col = R, ks0 = k0; bool valid = true;
    if (MODE == CV_UP) { const int pn = R >> 8, bj = (R >> 7) & 1, wc = (R >> 5) & 3, n = (R >> 4) & 1, fq = (R >> 2) & 3, e = R & 3; p = n ? s1 : s0; ld = FF; col = 128 * pn + 32 * wc + 8 * fq + 4 * bj + e; }
    if (MODE == CV_IN) {
        const int pn = R >> 8, rem = R & 255, bj = rem >> 7, wc = (rem >> 5) & 3; ld = DIN;
        const bool hperm = pn < 5 && !(pn == 2 && wc >= 2);
        const int j = hperm ? pg8::perm32(rem & 31) : (rem & 31);
        if (pn < 2) col = 64 * (4 * pn + wc) + 32 * bj + j;
        else if (pn == 2) {
            if (wc == 0) col = 512 + 32 * bj + j; else if (wc == 1) col = 1152 + 32 * bj + j; else if (wc == 2) col = 576 + 32 * bj + j;
            else { col = 1216 + (j & 7); valid = (bj == 0 && j < 8); }
        }
        else if (pn < 5) col = 640 + 64 * (4 * (pn - 3) + wc) + 32 * bj + j;
        else if (pn < 7) col = 1224 + 256 * (pn - 5) + rem;
        else if (pn < 11) col = 1736 + 256 * (pn - 7) + rem;
        else col = 2760 + 256 * (pn - 11) + rem;
    }
    if (MODE == CV_POOL) { const int g = R >> 7; p = s0 + g * 16384 + (R & 127) * 128; ld = 1; col = 0; valid = ((k0 >> 7) == g); ks0 = k0 & 127; }
    float tv[32];
#pragma unroll
    for (int i = 0; i < 32; ++i) { const int kk = 2 * i + (lane >> 5); tv[i] = valid ? p[(size_t)(ks0 + kk) * ld + col] : 0.f; }
#pragma unroll
    for (int i = 0; i < 32; ++i) { const int kk = 2 * i + (lane >> 5); float v_ = tv[i]; if (MODE == CV_POOL) v_ *= s1[k0 + kk]; if (gk) v_ *= gk[k0 + kk]; scr[kk * 33 + (lane & 31)] = v_; }
    asm volatile("s_waitcnt lgkmcnt(0)" ::: "memory");
    const int c = lane & 7;
#pragma unroll
    for (int j = 0; j < 4; ++j) { const int n = (lane >> 3) + 8 * j; const LAS float* s = scr + (8 * c) * 33 + n;
        u32x4 o; o.x = pg8::cvt_pk_bf16(s[0 * 33], s[1 * 33]); o.y = pg8::cvt_pk_bf16(s[2 * 33], s[3 * 33]); o.z = pg8::cvt_pk_bf16(s[4 * 33], s[5 * 33]); o.w = pg8::cvt_pk_bf16(s[6 * 33], s[7 * 33]);
        *(u32x4*)(WT + (size_t)(32 * nb + n) * K + k0 + 8 * c) = o; }
    asm volatile("s_waitcnt lgkmcnt(0)" ::: "memory");
}

typedef float f32x2 __attribute__((ext_vector_type(2)));
__device__ __forceinline__ f32x2 swiglu_pk(f32x2 a, f32x2 b) {
    const f32x2 t = a * (-1.44269504f); f32x2 e; e.x = __builtin_amdgcn_exp2f(t.x); e.y = __builtin_amdgcn_exp2f(t.y);
    const f32x2 d = e + 1.0f; f32x2 r; r.x = __builtin_amdgcn_rcpf(d.x); r.y = __builtin_amdgcn_rcpf(d.y);
    return (a * r) * b;
}
struct EpiUp {
    static constexpr bool PERM = false, AFTER_DRAIN = false;
    bf16_t* G; const float* ss;
    __device__ __forceinline__ void operator()(const f32x4 (&acc)[2][2][4][2], const pg8::Unit& u, int wr, int wc, int fr, int fq) const {
        float rs8[2][4];
        if (ss) row_rinv8(ss, u.pm * 256 + wr * 64 + fr, fq, rs8);
#pragma unroll
        for (int ai = 0; ai < 2; ++ai)
#pragma unroll
            for (int m = 0; m < 4; ++m) {
                const int r = u.pm * 256 + ai * 128 + wr * 64 + m * 16 + fr;
                const float rs = ss ? rs8[ai][m] : 1.0f;
                u32x4 w;
#pragma unroll
                for (int bj = 0; bj < 2; ++bj) {
                    const f32x4 a = acc[ai][bj][m][0], b = acc[ai][bj][m][1];
                    f32x2 a0 = {a[0], a[1]}, a1 = {a[2], a[3]}, b0 = {b[0], b[1]}, b1 = {b[2], b[3]};
                    if (ss) { a0 = a0 * rs; a1 = a1 * rs; b0 = b0 * rs; b1 = b1 * rs; }
                    const f32x2 g0 = swiglu_pk(a0, b0), g1 = swiglu_pk(a1, b1);
                    if (bj == 0) { w.x = pg8::cvt_pk_bf16(g0.x, g0.y); w.y = pg8::cvt_pk_bf16(g1.x, g1.y); } else { w.z = pg8::cvt_pk_bf16(g0.x, g0.y); w.w = pg8::cvt_pk_bf16(g1.x, g1.y); }
                }
                *(u32x4*)(G + (size_t)r * FF + u.pn * 128 + wc * 32 + 8 * fq) = w;
            }
    }
};
template <int PH> struct EpiRes {
    static constexpr bool PERM = true, AFTER_DRAIN = false;
    const float* x; float* out; unsigned char* ws;
    __device__ __forceinline__ void operator()(const f32x4 (&acc)[2][2][4][2], const pg8::Unit& u, int wr, int wc, int fr, int fq) const {
        constexpr bool RES_BF16 = PH != 2, OUT_F32 = PH == 9; constexpr float alpha = PH == 7 ? 1.0f : 0.5f;
        const float* resf = x; const bf16_t* resb = PH == 7 ? (const bf16_t*)out : (const bf16_t*)(ws + OFF_AB0);
        bf16_t* xb = PH == 2 ? (bf16_t*)out : (bf16_t*)(ws + OFF_AB0); float* ss = (float*)(ws + OFF_SS);
#pragma unroll
        for (int ai = 0; ai < 2; ++ai) {
            f32x4 r0[4][2], r1[4][2];
#pragma unroll
            for (int m = 0; m < 4; ++m)
#pragma unroll
                for (int bj = 0; bj < 2; ++bj) {
                    const size_t off = (size_t)(u.pm * 256 + ai * 128 + wr * 64 + m * 16 + fr) * DM + u.pn * 256 + bj * 128 + wc * 32 + 8 * fq;
                    if (RES_BF16) { const u32x4 w = *(const u32x4*)(resb + off); r0[m][bj] = (f32x4){bf_lo(w.x), bf_hi(w.x), bf_lo(w.y), bf_hi(w.y)}; r1[m][bj] = (f32x4){bf_lo(w.z), bf_hi(w.z), bf_lo(w.w), bf_hi(w.w)}; }
                    else { r0[m][bj] = *(const f32x4*)(resf + off); r1[m][bj] = *(const f32x4*)(resf + off + 4); }
                }
#pragma unroll
            for (int m = 0; m < 4; ++m) {
                const int r = u.pm * 256 + ai * 128 + wr * 64 + m * 16 + fr; float sq = 0.f;
#pragma unroll
                for (int bj = 0; bj < 2; ++bj) {
                    const size_t off = (size_t)r * DM + u.pn * 256 + bj * 128 + wc * 32 + 8 * fq;
                    const f32x4 o0 = r0[m][bj] + acc[ai][bj][m][0] * alpha, o1 = r1[m][bj] + acc[ai][bj][m][1] * alpha;
                    if (OUT_F32) { *(f32x4*)(out + off) = o0; *(f32x4*)(out + off + 4) = o1; }
                    else { sq += ((o0[0] * o0[0] + o0[1] * o0[1]) + (o0[2] * o0[2] + o0[3] * o0[3])) + ((o1[0] * o1[0] + o1[1] * o1[1]) + (o1[2] * o1[2] + o1[3] * o1[3]));
                           const u32x2 p0 = pack4(o0), p1 = pack4(o1); u32x4 w; w.x = p0.x; w.y = p0.y; w.z = p1.x; w.w = p1.y; *(u32x4*)(xb + off) = w; }
                }
                if (!OUT_F32) { sq += __shfl_xor(sq, 16); sq += __shfl_xor(sq, 32); if (fq == 0) ss[(size_t)r * 16 + u.pn * 4 + wc] = sq; }
            }
        }
    }
};
struct EpiIn {
    static constexpr bool PERM = false, AFTER_DRAIN = false;
    const float* ss; const float* cs; const float* sn; const float* qn; const float* kn;
    bf16_t *Q, *QI, *K, *KI, *VT; float *WI, *U; bf16_t *SGA, *SGP;
    __device__ __forceinline__ void operator()(const f32x4 (&acc)[2][2][4][2], const pg8::Unit& u, int wr, int wc, int fr, int fq) const {
        const int pn = u.pn;
        float rs8[2][4];
        row_rinv8(ss, u.pm * 256 + wr * 64 + fr, fq, rs8);
        const bool norm_unit = pn < 2 || (pn == 2 && wc == 0);
        f32x4 gain[2][2];
#pragma unroll
        for (int bj = 0; bj < 2; ++bj)
#pragma unroll
            for (int n = 0; n < 2; ++n) gain[bj][n] = norm_unit ? *(const f32x4*)((pn < 2 ? qn : kn) + 32 * bj + 8 * fq + 4 * n) : (f32x4){1.f, 1.f, 1.f, 1.f};
#pragma unroll
        for (int ai = 0; ai < 2; ++ai)
#pragma unroll
            for (int m = 0; m < 4; ++m) {
                const int r = u.pm * 256 + ai * 128 + wr * 64 + m * 16 + fr;
                const float rs = rs8[ai][m];
                f32x4 v[2][2];
#pragma unroll
                for (int bj = 0; bj < 2; ++bj)
#pragma unroll
                    for (int n = 0; n < 2; ++n) v[bj][n] = acc[ai][bj][m][n] * rs;
                if (pn < 5) {
                    const bool is_q = pn < 2, is_misc = pn == 2;
                    const bool do_norm = is_q || (is_misc && wc == 0), do_rope = !(is_misc && wc >= 2);
                    if (do_norm) {
                        float sq = 0.f;
#pragma unroll
                        for (int bj = 0; bj < 2; ++bj)
#pragma unroll
                            for (int n = 0; n < 2; ++n) sq += (v[bj][n][0] * v[bj][n][0] + v[bj][n][1] * v[bj][n][1]) + (v[bj][n][2] * v[bj][n][2] + v[bj][n][3] * v[bj][n][3]);
                        sq += __shfl_xor(sq, 16); sq += __shfl_xor(sq, 32);
                        const float rn = __builtin_amdgcn_rsqf(sq * (1.0f / 64.0f) + EPS);
#pragma unroll
                        for (int bj = 0; bj < 2; ++bj)
#pragma unroll
                            for (int n = 0; n < 2; ++n) v[bj][n] = v[bj][n] * rn * gain[bj][n];
                    }
                    if (do_rope) {
#pragma unroll
                        for (int n = 0; n < 2; ++n) {
                            const f32x4 c4 = *(const f32x4*)(cs + (size_t)r * 32 + 8 * fq + 4 * n), s4 = *(const f32x4*)(sn + (size_t)r * 32 + 8 * fq + 4 * n);
                            const f32x4 x1 = v[0][n], x2 = v[1][n];
                            v[0][n] = x1 * c4 - x2 * s4; v[1][n] = x2 * c4 + x1 * s4;
                        }
                    }
                    if (is_misc && wc == 2) {
                        const int b = r / SEQ, s = r % SEQ;
#pragma unroll
                        for (int bj = 0; bj < 2; ++bj)
#pragma unroll
                            for (int n = 0; n < 2; ++n)
#pragma unroll
                                for (int e = 0; e < 4; ++e) { const int d = 32 * bj + 16 * n + 4 * fq + e; VT[((size_t)b * 64 + d) * SEQ + s] = (bf16_t)(pg8::cvt_pk_bf16(v[bj][n][e], 0.f) & 0xffffu); }
                    } else if (is_misc && wc == 3) {
                        if (fq < 2) *(f32x4*)(WI + (size_t)r * 8 + 4 * fq) = v[0][0];
                    } else {
                        bf16_t* dst;
                        if (is_q) dst = Q + ((size_t)r * 8 + 4 * pn + wc) * 64;
                        else if (is_misc) dst = (wc == 0 ? K : KI) + (size_t)r * 64;
                        else dst = QI + ((size_t)r * 8 + 4 * (pn - 3) + wc) * 64;
#pragma unroll
                        for (int bj = 0; bj < 2; ++bj) { const u32x2 p0 = pack4(v[bj][0]), p1 = pack4(v[bj][1]); u32x4 w; w.x = p0.x; w.y = p0.y; w.z = p1.x; w.w = p1.y; *(u32x4*)(dst + 32 * bj + 8 * fq) = w; }
                    }
                } else if (pn < 7) {
#pragma unroll
                    for (int bj = 0; bj < 2; ++bj)
#pragma unroll
                        for (int n = 0; n < 2; ++n) *(f32x4*)(U + (size_t)r * 512 + 256 * (pn - 5) + 128 * bj + 32 * wc + 16 * n + 4 * fq) = v[bj][n];
                } else {
                    bf16_t* dst = (pn < 11) ? SGA + (size_t)r * DM + 256 * (pn - 7) : SGP + (size_t)r * DM + 256 * (pn - 11);
#pragma unroll
                    for (int bj = 0; bj < 2; ++bj)
#pragma unroll
                        for (int n = 0; n < 2; ++n) { f32x4 g;
#pragma unroll
                            for (int e = 0; e < 4; ++e) g[e] = sigmoidf_(v[bj][n][e]);
                            *(u32x2*)(dst + 128 * bj + 32 * wc + 16 * n + 4 * fq) = pack4(g); }
                }
            }
    }
};
struct EpiPlain {
    static constexpr bool PERM = false, AFTER_DRAIN = false;
    bf16_t* O; int ldo;
    __device__ __forceinline__ void operator()(const f32x4 (&acc)[2][2][4][2], const pg8::Unit& u, int wr, int wc, int fr, int fq) const {
#pragma unroll
        for (int ai = 0; ai < 2; ++ai)
#pragma unroll
            for (int m = 0; m < 4; ++m)
#pragma unroll
                for (int bj = 0; bj < 2; ++bj)
#pragma unroll
                    for (int n = 0; n < 2; ++n)
                        *(u32x2*)(O + (size_t)(u.pm * 256 + ai * 128 + wr * 64 + m * 16 + fr) * ldo + u.pn * 256 + bj * 128 + wc * 32 + n * 16 + 4 * fq) = pack4(acc[ai][bj][m][n]);
    }
};
template <int STEP> struct EpiProj {
    static constexpr bool PERM = true, AFTER_DRAIN = false;
    const bf16_t* SG; bf16_t* M1; bf16_t* MG; const float* bias;
    __device__ __forceinline__ void operator()(const f32x4 (&acc)[2][2][4][2], const pg8::Unit& u, int wr, int wc, int fr, int fq) const {
        f32x4 b0[2], b1[2];
#pragma unroll
        for (int bj = 0; bj < 2; ++bj) { const int c = u.pn * 256 + bj * 128 + wc * 32 + 8 * fq; b0[bj] = (f32x4){0.f, 0.f, 0.f, 0.f}; b1[bj] = b0[bj]; if (STEP == 1) { b0[bj] = *(const f32x4*)(bias + c); b1[bj] = *(const f32x4*)(bias + c + 4); } }
#pragma unroll
        for (int ai = 0; ai < 2; ++ai) {
            u32x4 gw[4][2], mw[4][2];
#pragma unroll
            for (int m = 0; m < 4; ++m)
#pragma unroll
                for (int bj = 0; bj < 2; ++bj) {
                    const size_t off = (size_t)(u.pm * 256 + ai * 128 + wr * 64 + m * 16 + fr) * DM + u.pn * 256 + bj * 128 + wc * 32 + 8 * fq;
                    gw[m][bj] = *(const u32x4*)(SG + off); if (STEP == 1) mw[m][bj] = *(const u32x4*)(M1 + off);
                }
#pragma unroll
            for (int m = 0; m < 4; ++m)
#pragma unroll
                for (int bj = 0; bj < 2; ++bj) {
                    const size_t off = (size_t)(u.pm * 256 + ai * 128 + wr * 64 + m * 16 + fr) * DM + u.pn * 256 + bj * 128 + wc * 32 + 8 * fq;
                    const u32x4 g = gw[m][bj];
                    const f32x4 g0 = {bf_lo(g.x), bf_hi(g.x), bf_lo(g.y), bf_hi(g.y)}, g1 = {bf_lo(g.z), bf_hi(g.z), bf_lo(g.w), bf_hi(g.w)};
                    f32x4 o0, o1;
                    if (STEP == 0) { o0 = g0 * acc[ai][bj][m][0]; o1 = g1 * acc[ai][bj][m][1]; }
                    else { const u32x4 mm = mw[m][bj];
                           o0 = (f32x4){bf_lo(mm.x), bf_hi(mm.x), bf_lo(mm.y), bf_hi(mm.y)} + g0 * (acc[ai][bj][m][0] + b0[bj]);
                           o1 = (f32x4){bf_lo(mm.z), bf_hi(mm.z), bf_lo(mm.w), bf_hi(mm.w)} + g1 * (acc[ai][bj][m][1] + b1[bj]); }
                    const u32x2 p0 = pack4(o0), p1 = pack4(o1); u32x4 w; w.x = p0.x; w.y = p0.y; w.z = p1.x; w.w = p1.y;
                    *(u32x4*)((STEP == 0 ? M1 : MG) + off) = w;
                }
        }
    }
};

__device__ __forceinline__ int count_gt8(int c, unsigned mid, unsigned k0, unsigned k1, unsigned k2, unsigned k3, unsigned k4, unsigned k5, unsigned k6, unsigned k7) {
    unsigned long long m0, m1, m2, m3, m4, m5, m6, m7; int t0, t1;
    asm volatile("v_cmp_lt_u32_e64 %[m0], %[mid], %[k0]\n\tv_cmp_lt_u32_e64 %[m1], %[mid], %[k1]\n\tv_cmp_lt_u32_e64 %[m2], %[mid], %[k2]\n\tv_cmp_lt_u32_e64 %[m3], %[mid], %[k3]\n\t"
                 "v_cmp_lt_u32_e64 %[m4], %[mid], %[k4]\n\tv_cmp_lt_u32_e64 %[m5], %[mid], %[k5]\n\tv_cmp_lt_u32_e64 %[m6], %[mid], %[k6]\n\tv_cmp_lt_u32_e64 %[m7], %[mid], %[k7]\n\t"
                 "s_bcnt1_i32_b64 %[t0], %[m0]\n\ts_bcnt1_i32_b64 %[t1], %[m1]\n\ts_add_i32 %[c], %[c], %[t0]\n\ts_bcnt1_i32_b64 %[t0], %[m2]\n\ts_add_i32 %[c], %[c], %[t1]\n\ts_bcnt1_i32_b64 %[t1], %[m3]\n\t"
                 "s_add_i32 %[c], %[c], %[t0]\n\ts_bcnt1_i32_b64 %[t0], %[m4]\n\ts_add_i32 %[c], %[c], %[t1]\n\ts_bcnt1_i32_b64 %[t1], %[m5]\n\ts_add_i32 %[c], %[c], %[t0]\n\ts_bcnt1_i32_b64 %[t0], %[m6]\n\t"
                 "s_add_i32 %[c], %[c], %[t1]\n\ts_bcnt1_i32_b64 %[t1], %[m7]\n\ts_add_i32 %[c], %[c], %[t0]\n\ts_add_i32 %[c], %[c], %[t1]"
                 : [c] "+s"(c), [m0] "=&s"(m0), [m1] "=&s"(m1), [m2] "=&s"(m2), [m3] "=&s"(m3), [m4] "=&s"(m4), [m5] "=&s"(m5), [m6] "=&s"(m6), [m7] "=&s"(m7), [t0] "=&s"(t0), [t1] "=&s"(t1)
                 : [mid] "s"(mid), [k0] "v"(k0), [k1] "v"(k1), [k2] "v"(k2), [k3] "v"(k3), [k4] "v"(k4), [k5] "v"(k5), [k6] "v"(k6), [k7] "v"(k7)
                 : "scc");
    return c;
}
__device__ __forceinline__ unsigned ord_key(float v) { const unsigned b = __float_as_uint(v); return (b & 0x80000000u) ? ~b : (b | 0x80000000u); }

__device__ __forceinline__ void select_row(LAS float* srow, int t, int nreg, int lane, unsigned kept) {
    LAS unsigned* mrow = (LAS unsigned*)srow;
    const int ngrp = (nreg + 7) >> 3;
    unsigned ku[32];
#pragma unroll
    for (int g = 0; g < 4; ++g) {
        if (g < ngrp) {
#pragma unroll
            for (int j = 0; j < 8; ++j) { const int i = 8 * g + j, key = 64 * i + lane; const float sv = srow[key]; ku[i] = ord_key((key <= t) ? sv : -__builtin_inff()); }
        } else {
#pragma unroll
            for (int j = 0; j < 8; ++j) ku[8 * g + j] = 0x007fffffu;
        }
    }
    if (t + 1 <= 256) {
#pragma unroll
        for (int g = 0; g < 4; ++g) if (g < ngrp) {
#pragma unroll
            for (int j = 0; j < 8; ++j) { const int key = 64 * (8 * g + j) + lane; mrow[key] = (key <= t) ? kept : 0xff800000u; }
        }
        return;
    }
    unsigned lo = 0u, hi = 0xffffffffu; int chi = 0; bool exact = false;
    while (hi - lo > 1u) {
        const unsigned mid = lo + ((hi - lo) >> 1); int c = 0;
#pragma unroll
        for (int g = 0; g < 4; ++g) if (g < ngrp) {
            c = count_gt8(c, mid, ku[8 * g], ku[8 * g + 1], ku[8 * g + 2], ku[8 * g + 3], ku[8 * g + 4], ku[8 * g + 5], ku[8 * g + 6], ku[8 * g + 7]);
        }
        if (c == 256) { hi = mid; chi = c; exact = true; break; }
        if (c > 256) lo = mid; else { hi = mid; chi = c; }
    }
    int need = exact ? 0 : (256 - chi);
#pragma unroll
    for (int g = 0; g < 4; ++g) if (g < ngrp) {
#pragma unroll
        for (int j = 0; j < 8; ++j) {
            const int i = 8 * g + j; bool keep = ku[i] > hi;
            if (need > 0) {
                unsigned long long eq = __ballot(ku[i] == hi); int cnt = __popcll(eq);
                while (cnt > need) { eq &= ~(1ull << (63 - __builtin_clzll(eq))); --cnt; }
                need -= cnt; keep = keep || ((eq >> lane) & 1ull);
            }
            mrow[64 * i + lane] = keep ? kept : 0xff800000u;
        }
    }
}

struct P4Ptrs { const bf16_t *Q, *QI, *K, *KI, *VT; const float* WI; bf16_t* Y; float bc; };

__device__ __forceinline__ void p4_unit(LAS unsigned char* lds, const P4Ptrs& P, int b, int q0, int wid, int lane) {
    LAS float* sc = (LAS float*)lds;
    const int lg = lane >> 4, ln = lane & 15; const size_t tb = (size_t)b * SEQ;
    const int nstep = (q0 + 16 + 31) / 32;
    {
        bf16x8 aX[4][2], aY[4][2]; float w[4][8];
        const float idx_scale = 0.125f * 0.35355339059327373f;
#pragma unroll
        for (int g = 0; g < 4; ++g) {
            const bf16_t* pq = P.QI + ((tb + q0 + 4 * g + (ln >> 2)) * 8 + (ln & 3)) * 64 + 8 * lg;
#pragma unroll
            for (int ks = 0; ks < 2; ++ks) { aX[g][ks] = *(const bf16x8*)(pq + 32 * ks); aY[g][ks] = *(const bf16x8*)(pq + 256 + 32 * ks); }
            const f32x4* pw = (const f32x4*)(P.WI + (tb + q0 + 4 * g + lg) * 8); const f32x4 w0 = pw[0], w1 = pw[1];
#pragma unroll
            for (int e = 0; e < 4; ++e) { w[g][e] = w0[e] * idx_scale; w[g][4 + e] = w1[e] * idx_scale; }
        }
        const int ntile = q0 / 16 + 1;
        const bf16_t* pk = P.KI + (tb + 16 * wid + ln) * 64 + 8 * lg;
        bf16x8 b0n = {0, 0, 0, 0, 0, 0, 0, 0}, b1n = b0n;
        if (wid < ntile) { b0n = *(const bf16x8*)pk; b1n = *(const bf16x8*)(pk + 32); }
        for (int kt = wid; kt < ntile; kt += 8) {
            const bf16x8 b0 = b0n, b1 = b1n;
            pk += 8 * 16 * 64;
            if (kt + 8 < ntile) { b0n = *(const bf16x8*)pk; b1n = *(const bf16x8*)(pk + 32); }
#pragma unroll
            for (int g = 0; g < 4; ++g) {
                f32x4 x = {0.f, 0.f, 0.f, 0.f}, y = {0.f, 0.f, 0.f, 0.f};
                x = __builtin_amdgcn_mfma_f32_16x16x32_bf16(aX[g][0], b0, x, 0, 0, 0); x = __builtin_amdgcn_mfma_f32_16x16x32_bf16(aX[g][1], b1, x, 0, 0, 0);
                y = __builtin_amdgcn_mfma_f32_16x16x32_bf16(aY[g][0], b0, y, 0, 0, 0); y = __builtin_amdgcn_mfma_f32_16x16x32_bf16(aY[g][1], b1, y, 0, 0, 0);
                float s = 0.f;
#pragma unroll
                for (int e = 0; e < 4; ++e) { s += w[g][e] * fmaxf(x[e], 0.f); s += w[g][4 + e] * fmaxf(y[e], 0.f); }
                sc[(4 * g + lg) * SCS + 16 * kt + ln] = s;
            }
        }
    }
    __syncthreads();
    constexpr int HPW = 2, NHG = 8 / HPW, NKS = 8 / NHG, CBW = HPW * 16 + HPW; const int hg = wid / NKS, ksp = wid % NKS;
    bf16x8 qb[HPW][2];
#pragma unroll
    for (int h = 0; h < HPW; ++h) { const bf16_t* pq = P.Q + ((tb + q0 + ln) * 8 + HPW * hg + h) * 64 + 8 * lg; qb[h][0] = *(const bf16x8*)pq; qb[h][1] = *(const bf16x8*)(pq + 32); }
    const int tid = wid * 64 + lane, srow_ = tid >> 3, sch = tid & 7;
    const bf16_t* gk = P.K + (tb + srow_) * 64 + 8 * sch;
    const bf16_t* gv = P.VT + ((size_t)b * 64 + srow_) * SEQ + 8 * sch;
    u32x4 rk = *(const u32x4*)gk, rv = *(const u32x4*)gv;
    {
        const int nreg = (32 * nstep + 63) >> 6;
        const unsigned kept = __float_as_uint(-P.bc);
        select_row(sc + (2 * wid) * SCS, q0 + 2 * wid, nreg, lane, kept);
        select_row(sc + (2 * wid + 1) * SCS, q0 + 2 * wid + 1, nreg, lane, kept);
    }
    __syncthreads();
    {
        f32x4 o[HPW][4]; float ls[HPW];
#pragma unroll
        for (int h = 0; h < HPW; ++h) { ls[h] = 0.f;
#pragma unroll
            for (int dt = 0; dt < 4; ++dt) o[h][dt] = (f32x4){0.f, 0.f, 0.f, 0.f}; }
        const float cl = 0.125f * 1.44269504f;
        const LAS float* brow = (const LAS float*)sc + ln * SCS + 4 * lg;
        LAS unsigned char* lk = lds + KT_OFF + srow_ * 144 + sch * 16;
        LAS unsigned char* lv = lds + VT_OFF + srow_ * 144 + sch * 16;
        const LAS unsigned char* fk = lds + KT_OFF + (32 * ksp + ln) * 144 + 16 * lg;
        const LAS unsigned char* fv = lds + VT_OFF + ln * 144 + 64 * ksp + 8 * lg;
        const int ntile = (nstep + 1) >> 1;
        for (int tt = 0; tt < ntile; ++tt) {
            __syncthreads();
            *(LAS u32x4*)lk = rk; *(LAS u32x4*)lv = rv;
            __syncthreads();
            if (tt + 1 < ntile) { gk += 64 * 64; gv += 64; rk = *(const u32x4*)gk; rv = *(const u32x4*)gv; }
            const int st = 2 * tt + ksp;
            if (st < nstep) {
                const bf16x8 k0 = *(const LAS bf16x8*)fk, k1 = *(const LAS bf16x8*)(fk + 64), k2 = *(const LAS bf16x8*)(fk + 16 * 144), k3 = *(const LAS bf16x8*)(fk + 16 * 144 + 64);
                union { u32x4 u; bf16x8 v; } va[4];
#pragma unroll
                for (int dt = 0; dt < 4; ++dt) { const u32x2 v0 = *(const LAS u32x2*)(fv + dt * 16 * 144), v1 = *(const LAS u32x2*)(fv + dt * 16 * 144 + 32); va[dt].u.x = v0.x; va[dt].u.y = v0.y; va[dt].u.z = v1.x; va[dt].u.w = v1.y; }
                const f32x4 ba = *(const LAS f32x4*)(brow + 32 * st), bb = *(const LAS f32x4*)(brow + 32 * st + 16);
#pragma unroll
                for (int h = 0; h < HPW; ++h) {
                    f32x4 sa = {0.f, 0.f, 0.f, 0.f}, sb = {0.f, 0.f, 0.f, 0.f};
                    sa = __builtin_amdgcn_mfma_f32_16x16x32_bf16(k0, qb[h][0], sa, 0, 0, 0); sa = __builtin_amdgcn_mfma_f32_16x16x32_bf16(k1, qb[h][1], sa, 0, 0, 0);
                    sb = __builtin_amdgcn_mfma_f32_16x16x32_bf16(k2, qb[h][0], sb, 0, 0, 0); sb = __builtin_amdgcn_mfma_f32_16x16x32_bf16(k3, qb[h][1], sb, 0, 0, 0);
                    float pa[4], pb[4], ps = 0.f;
#pragma unroll
                    for (int e = 0; e < 4; ++e) { pa[e] = __builtin_amdgcn_exp2f(sa[e] * cl + ba[e]); pb[e] = __builtin_amdgcn_exp2f(sb[e] * cl + bb[e]); ps += pa[e] + pb[e]; }
                    ls[h] += ps;
                    union { u32x4 u; bf16x8 v; } p8;
                    p8.u.x = pg8::cvt_pk_bf16(pa[0], pa[1]); p8.u.y = pg8::cvt_pk_bf16(pa[2], pa[3]); p8.u.z = pg8::cvt_pk_bf16(pb[0], pb[1]); p8.u.w = pg8::cvt_pk_bf16(pb[2], pb[3]);
#pragma unroll
                    for (int dt = 0; dt < 4; ++dt) o[h][dt] = __builtin_amdgcn_mfma_f32_16x16x32_bf16(va[dt].v, p8.v, o[h][dt], 0, 0, 0);
                }
            }
        }
        __syncthreads();
        LAS float* cb = (LAS float*)lds;
        if (ksp != 0) {
            LAS float* c0 = cb + (size_t)((hg * (NKS - 1) + ksp - 1) * CBW) * 64 + lane;
#pragma unroll
            for (int h = 0; h < HPW; ++h) {
#pragma unroll
                for (int dt = 0; dt < 4; ++dt)
#pragma unroll
                    for (int e = 0; e < 4; ++e) c0[((h * 4 + dt) * 4 + e) * 64] = o[h][dt][e];
                c0[(HPW * 16 + h) * 64] = ls[h];
            }
        }
        __syncthreads();
        if (ksp == 0) {
#pragma unroll
            for (int j = 0; j < NKS - 1; ++j) {
                const LAS float* c0 = cb + (size_t)((hg * (NKS - 1) + j) * CBW) * 64 + lane;
#pragma unroll
                for (int h = 0; h < HPW; ++h) {
#pragma unroll
                    for (int dt = 0; dt < 4; ++dt)
#pragma unroll
                        for (int e = 0; e < 4; ++e) o[h][dt][e] += c0[((h * 4 + dt) * 4 + e) * 64];
                    ls[h] += c0[(HPW * 16 + h) * 64];
                }
            }
#pragma unroll
            for (int h = 0; h < HPW; ++h) {
                float l = ls[h]; l += __shfl_xor(l, 16); l += __shfl_xor(l, 32);
                const float inv = 1.0f / l;
                bf16_t* py = P.Y + (tb + q0 + ln) * 512 + (HPW * hg + h) * 64 + 4 * lg;
#pragma unroll
                for (int dt = 0; dt < 4; ++dt) *(u32x2*)(py + 16 * dt) = pack4(o[h][dt] * inv);
            }
        }
    }
    __syncthreads();
}

__device__ __forceinline__ void fold_bias(const float* pb, const float* psc, const float* pp, float* BIASF, int tidx, int nthr) {
    for (int o = tidx; o < DM * 16; o += nthr) {
        const int n = o >> 4, kp = o & 15; float acc = 0.f;
#pragma unroll 8
        for (int j = 0; j < 32; ++j) { const int k = 32 * kp + j; acc += (pb[k] * psc[k]) * pp[(size_t)k * DM + n]; }
        acc += __shfl_xor(acc, 1); acc += __shfl_xor(acc, 2); acc += __shfl_xor(acc, 4); acc += __shfl_xor(acc, 8);
        if (kp == 0) BIASF[n] = acc;
    }
}

#define XB_TMO      128
#define XB_XCNT(j)  (256  + 64 * (j))
#define XB_XSUB(j)  (1280 + 64 * (j))
#define XB_XGEN(j)  (2304 + 64 * (j))
#define XB_TOP      3328
#define XB_TOPGEN   3392
#define XCD_BAR_WORDS 3456
#define XB_SPIN_CAP (1u << 18)

__device__ __forceinline__ unsigned xb_ld(unsigned* p)              { return __hip_atomic_load(p, __ATOMIC_RELAXED, __HIP_MEMORY_SCOPE_AGENT); }
__device__ __forceinline__ unsigned xb_add(unsigned* p, unsigned v) { return __hip_atomic_fetch_add(p, v, __ATOMIC_RELAXED, __HIP_MEMORY_SCOPE_AGENT); }
__device__ __forceinline__ unsigned xb_xcc_id() { return (unsigned)__builtin_amdgcn_s_getreg((3 << 11) | 20) & 0xFu; }
#define XB_SPIN(cond, bar) do { unsigned _sp = 0; while (cond) { __builtin_amdgcn_s_sleep(1); \
    if ((++_sp & 255u) == 0u) { if (xb_ld(&(bar)[XB_TMO])) break; if (_sp > XB_SPIN_CAP) { atomicAdd(&(bar)[XB_TMO], 1u); break; } } } } while (0)

struct XcdBarrier {
    unsigned* bar; unsigned x;
    volatile LAS unsigned* st;
};

__device__ __forceinline__ XcdBarrier xcd_barrier_post(unsigned* bar, volatile LAS unsigned* st) {
    XcdBarrier b; b.bar = bar; b.x = xb_xcc_id(); b.st = st;
    if (threadIdx.x == 0) (void)xb_add(&bar[XB_XCNT(b.x)], 1u);
    return b;
}
__device__ __forceinline__ void xcd_barrier_complete(unsigned* bar, unsigned x, unsigned& nloc, unsigned& nx) {
    const unsigned G = gridDim.x * gridDim.y * gridDim.z;
    unsigned sum, cnt, mine, sp = 0u;
    for (;;) {
        sum = 0u; cnt = 0u; mine = 0u;
#pragma unroll
        for (unsigned j = 0; j < 16; ++j) { const unsigned c = xb_ld(&bar[XB_XCNT(j)]); sum += c; cnt += (c > 0u) ? 1u : 0u; mine = (j == x) ? c : mine; }
        if (sum == G) break;
        __builtin_amdgcn_s_sleep(1);
        if ((++sp & 255u) == 0u) { if (xb_ld(&bar[XB_TMO])) break; if (sp > XB_SPIN_CAP) { atomicAdd(&bar[XB_TMO], 1u); break; } }
    }
    nloc = mine > 0u ? mine : 1u; nx = cnt > 0u ? cnt : 1u;
}

__device__ __forceinline__ void xcd_barrier(const XcdBarrier& b) {
    asm volatile("s_waitcnt vmcnt(0)" ::: "memory");
    __syncthreads();
    if (threadIdx.x == 0) {
        unsigned* bar = b.bar;
        __builtin_amdgcn_s_waitcnt(0);
        unsigned nloc = b.st[0], nx = b.st[1];
        if (nloc == 0u) { xcd_barrier_complete(bar, b.x, nloc, nx); b.st[0] = nloc; b.st[1] = nx; }
        const unsigned old = xb_add(&bar[XB_XSUB(b.x)], 1u);
        const unsigned gen = old / nloc;
        if (old + 1u == (gen + 1u) * nloc) {
            __builtin_amdgcn_fence(__ATOMIC_RELEASE, "agent");
            asm volatile("s_waitcnt vmcnt(0)" ::: "memory");
            const unsigned og = xb_add(&bar[XB_TOP], 1u);
            const unsigned tg = og / nx;
            if (og + 1u == (tg + 1u) * nx) xb_add(&bar[XB_TOPGEN], 1u);
            else XB_SPIN(xb_ld(&bar[XB_TOPGEN]) == tg, bar);
            __builtin_amdgcn_fence(__ATOMIC_ACQUIRE, "agent");
            xb_add(&bar[XB_XGEN(b.x)], 1u);
            asm volatile("s_waitcnt vmcnt(0)" ::: "memory");
        } else {
            XB_SPIN(xb_ld(&bar[XB_XGEN(b.x)]) == gen, bar);
            __builtin_amdgcn_fence(__ATOMIC_ACQUIRE, "agent");
            asm volatile("s_waitcnt vmcnt(0)" ::: "memory");
        }
    }
    __syncthreads();
}

struct Args { const void* in[20]; float* out; unsigned char* ws; int ph_lo, ph_hi; };
#ifndef MK_N_LAUNCHES
#define MK_N_LAUNCHES 1
#endif
constexpr int NPHASE = 10;

__global__ void __launch_bounds__(512) fwd_kernel(Args a) {
    extern __shared__ __attribute__((aligned(16))) unsigned char lds_raw[];
    LAS unsigned char* lds = (LAS unsigned char*)lds_raw;
    const int tid = threadIdx.x, lane = tid & 63, wid = __builtin_amdgcn_readfirstlane(tid >> 6);
    const int G = gridDim.x, bx = blockIdx.x;
    const int lo = a.ph_lo, hi = a.ph_hi;
    unsigned char* ws = a.ws;
    const float* x = (const float*)a.in[0]; const int* positions = (const int*)a.in[1];
    float* out = a.out;
    bf16_t* W13A = (bf16_t*)(ws + OFF_W13A); bf16_t* W2A = (bf16_t*)(ws + OFF_W2A); bf16_t* WIN = (bf16_t*)(ws + OFF_WIN); bf16_t* WPOOL = (bf16_t*)(ws + OFF_WPOOL);
    bf16_t* WPA = (bf16_t*)(ws + OFF_WPA); bf16_t* WPP = (bf16_t*)(ws + OFF_WPP); bf16_t* WOUT = (bf16_t*)(ws + OFF_WOUT); bf16_t* W13B = (bf16_t*)(ws + OFF_W13B); bf16_t* W2B = (bf16_t*)(ws + OFF_W2B);
    float* CS = (float*)(ws + OFF_ROPE); float* SN = CS + (size_t)T * 32; float* SS = (float*)(ws + OFF_SS);
    bf16_t* AB0 = (bf16_t*)(ws + OFF_AB0); bf16_t* AB1 = (bf16_t*)(ws + OFF_AB1);
    bf16_t* SGA = (bf16_t*)(ws + OFF_SGA); bf16_t* SGP = (bf16_t*)(ws + OFF_SGP); bf16_t* Qb = (bf16_t*)(ws + OFF_Q); bf16_t* QIb = (bf16_t*)(ws + OFF_QI);
    float* Ub = (float*)(ws + OFF_U); bf16_t* Kb = (bf16_t*)(ws + OFF_K); bf16_t* KIb = (bf16_t*)(ws + OFF_KI); bf16_t* VTb = (bf16_t*)(ws + OFF_VT); float* WIb = (float*)(ws + OFF_WI);
    bf16_t* Gb = (bf16_t*)(ws + OFF_G); bf16_t* M1 = (bf16_t*)(ws + OFF_M1); float* BIASF = (float*)(ws + OFF_BIASF); bf16_t* WPPF = (bf16_t*)(ws + OFF_WPPF);
#if MK_N_LAUNCHES == 1
    cg::grid_group grid = cg::this_grid();
    XcdBarrier xbar; xbar.bar = (unsigned*)(ws + OFF_BAR); xbar.x = 0; xbar.st = (volatile LAS unsigned*)(lds + LDS_BYTES - 16);
    if (tid < 4) ((LAS unsigned*)(lds + LDS_BYTES - 16))[tid] = 0u;
    if (bx == 0) for (int i = tid; i < XCD_BAR_WORDS; i += 512) ((unsigned*)(ws + OFF_BAR))[i] = 0u;
    __syncthreads();
#define SEAM(k) do { if (lo <= (k) && (k) + 1 < hi) { if ((k) == 0) { grid.sync(); xbar = xcd_barrier_post((unsigned*)(ws + OFF_BAR), (volatile LAS unsigned*)(lds + LDS_BYTES - 16)); } else xcd_barrier(xbar); } } while (0)
#else
#define SEAM(k) do { } while (0)
#endif
#define IN(k) (lo <= (k) && (k) < hi)

    if (IN(0)) {
        LAS float* scr = (LAS float*)(lds + wid * 8448);
        const int gw = bx * 8 + wid, NGW = G * 8;
        constexpr int I_UP = (DM / 64) * (NUP / 32), I_DN = (FF / 64) * (DM / 32), I_PL = (512 / 64) * (512 / 32), I_PR = (512 / 64) * (DM / 32);
        constexpr int NITEMS = I_UP + I_DN + I_PL + 2 * I_PR;
        for (int it = gw; it < NITEMS; it += NGW) {
            int r = it;
            if (r < I_UP) { cvt_item<CV_UP>((const float*)a.in[3], (const float*)a.in[4], DM, NUP / 32, W13A, scr, r, lane); continue; } r -= I_UP;
            if (r < I_DN) { cvt_item<CV_NAT>((const float*)a.in[5], nullptr, FF, DM / 32, W2A, scr, r, lane); continue; } r -= I_DN;
            if (r < I_PR) { cvt_item<CV_NAT>((const float*)a.in[13], nullptr, 512, DM / 32, WPA, scr, r, lane); continue; } r -= I_PR;
            if (r < I_PR) { cvt_item<CV_NAT>((const float*)a.in[14], nullptr, 512, DM / 32, WPP, scr, r, lane); continue; } r -= I_PR;
            cvt_item<CV_POOL>((const float*)a.in[10], (const float*)a.in[12], 512, 512 / 32, WPOOL, scr, r, lane);
        }
        const float* g1 = (const float*)a.in[2];
        for (int m = 2 * gw; m < T; m += 2 * NGW) {
            const f32x4* xr = (const f32x4*)(x + (size_t)m * DM) + lane; f32x4 v[2][4]; float s[2] = {0.f, 0.f};
#pragma unroll
            for (int q = 0; q < 2; ++q)
#pragma unroll
                for (int j = 0; j < 4; ++j) v[q][j] = xr[q * (DM / 4) + 64 * j];
#pragma unroll
            for (int q = 0; q < 2; ++q) {
#pragma unroll
                for (int j = 0; j < 4; ++j) s[q] += (v[q][j][0] * v[q][j][0] + v[q][j][1] * v[q][j][1]) + (v[q][j][2] * v[q][j][2] + v[q][j][3] * v[q][j][3]);
                const float rinv = 1.0f / sqrtf(wave_sum(s[q]) * (1.0f / DM) + EPS);
#pragma unroll
                for (int j = 0; j < 4; ++j) { const f32x4 gv = *((const f32x4*)g1 + lane + 64 * j); *((u32x2*)(AB0 + (size_t)(m + q) * DM) + lane + 64 * j) = pack4(v[q][j] * rinv * gv); }
            }
        }
        asm volatile("s_waitcnt vmcnt(0) lgkmcnt(0)" ::: "memory");
        __syncthreads();
    }
    SEAM(0);
    if (IN(1)) { pg8::Gemm g{AB0, W13A, T, NUP, DM}; pg8::StaticOrder S; S.init(T, NUP, G, bx); EpiUp E{Gb, nullptr}; pg8::gemm_phase<EpiUp, pg8::StaticOrder>(lds, g, S, E, nullptr);
        const int nun = (T / 256) * (NUP / 256), rem = nun % G, ntail = rem ? G - rem : G, ti = rem ? bx - rem : bx;
        if (ti >= 0) {
            if (ti < 8) { pg8::Gemm g2{WPP, WPOOL, DM, 512, 512}; pg8::StaticOrder S2; S2.init(DM, 512, 8, ti); EpiPlain E2{WPPF, 512}; pg8::gemm_phase<EpiPlain, pg8::StaticOrder>(lds, g2, S2, E2, nullptr); }
            else {
            if (ti < 40) fold_bias((const float*)a.in[11], (const float*)a.in[12], (const float*)a.in[14], BIASF, (ti - 8) * 512 + tid, 32 * 512);
            if (ntail > 8) {
                const int nw = (ntail - 8) * 8, w0 = (ti - 8) * 8 + wid; LAS float* scr = (LAS float*)(lds + wid * 8448);
                for (int it = w0; it < (DM / 64) * (NIN / 32); it += nw) cvt_item<CV_IN>((const float*)a.in[7], nullptr, DM, NIN / 32, WIN, scr, it, lane, (const float*)a.in[6]);
                for (int i = (ti - 8) * 512 + tid; i < T * 32; i += (ntail - 8) * 512) {
                    const int tok = i >> 5, f = i & 31;
                    const float ang = (float)positions[tok] * INV_FREQ[f];
                    const double rev = (double)ang * 0.15915494309189535; const float fr = (float)(rev - __builtin_rint(rev));
                    CS[i] = __builtin_amdgcn_cosf(fr); SN[i] = __builtin_amdgcn_sinf(fr);
                }
            }
            }
        }
    }
    SEAM(1);
    bf16_t* XB = (bf16_t*)out;
    if (IN(2)) { pg8::Gemm g{Gb, W2A, T, DM, FF}; pg8::StaticOrder S; S.init(T, DM, G, bx); EpiRes<2> E{x, out, ws}; pg8::gemm_phase<EpiRes<2>, pg8::StaticOrder>(lds, g, S, E, nullptr); }
    SEAM(2);
    if (IN(3)) { pg8::Gemm g{XB, WIN, T, NIN, DM}; pg8::StaticOrder S; S.init(T, NIN, G, bx);
        EpiIn E{SS, CS, SN, (const float*)a.in[8], (const float*)a.in[9], Qb, QIb, Kb, KIb, VTb, WIb, Ub, SGA, SGP};
        pg8::gemm_phase<EpiIn, pg8::StaticOrder>(lds, g, S, E, nullptr);
        const int nun = (T / 256) * (NIN / 256), rem = nun % G, ntail = rem ? G - rem : G, ti = rem ? bx - rem : bx;
        if (ti >= 0) {
            constexpr int I_UP = (DM / 64) * (NUP / 32), I_DN = (FF / 64) * (DM / 32), I_OUT = (DM / 64) * (DM / 32);
            const int nw = ntail * 8, w0 = ti * 8 + wid; LAS float* scr = (LAS float*)(lds + wid * 8448);
            for (int it = w0; it < I_UP + I_DN + I_OUT; it += nw) {
                int r = it;
                if (r < I_UP) { cvt_item<CV_UP>((const float*)a.in[17], (const float*)a.in[18], DM, NUP / 32, W13B, scr, r, lane, (const float*)a.in[16]); continue; } r -= I_UP;
                if (r < I_DN) { cvt_item<CV_NAT>((const float*)a.in[19], nullptr, FF, DM / 32, W2B, scr, r, lane); continue; } r -= I_DN;
                cvt_item<CV_NAT>((const float*)a.in[15], nullptr, DM, DM / 32, WOUT, scr, r, lane);
            }
        }
    }
    SEAM(3);
    if (IN(4)) {
        bf16_t* PLD = AB0 + (size_t)T * 512;
        for (int ch = bx; ch < T / 32; ch += G) {
            const int g = tid >> 7, win = 2 << g, t0 = ch * 32, pos0 = t0 % SEQ;
            float h[47];
#pragma unroll
            for (int rr = 0; rr < 47; ++rr) h[rr] = (pos0 + rr - 15 >= 0) ? Ub[(size_t)(t0 + rr - 15) * 512 + tid] : 0.f;
#pragma unroll
            for (int r = 0; r < 32; ++r) {
                const int n = (pos0 + r + 1 < win) ? pos0 + r + 1 : win; float s = 0.f;
#pragma unroll
                for (int j = 0; j < 16; ++j) s += (j < n) ? h[15 + r - j] : 0.f;
                PLD[(size_t)(t0 + r) * 512 + tid] = (bf16_t)(pg8::cvt_pk_bf16(s / (float)n - h[15 + r], 0.f) & 0xffffu);
            }
        }
        float gq = fabsf(((const float*)a.in[8])[lane]), gk = fabsf(((const float*)a.in[9])[lane]);
#pragma unroll
        for (int o_ = 1; o_ < 64; o_ <<= 1) { gq = fmaxf(gq, __shfl_xor(gq, o_)); gk = fmaxf(gk, __shfl_xor(gk, o_)); }
        const P4Ptrs P{Qb, QIb, Kb, KIb, VTb, WIb, AB0, 8.0f * gq * gk * 1.02f * 1.44269504f};
        for (int i = 0; ; ++i) {
            const int sidx = i * G + bx; if (sidx >= T / 16) break;
            const int rnd = sidx / 256, j = sidx % 256, s2 = rnd * 256 + ((rnd & 1) ? 255 - j : j);
            p4_unit(lds, P, s2 & 7, (s2 >> 3) * 16, wid, lane);
        }
    }
    SEAM(4);
    if (IN(6)) {
        { pg8::Gemm g{AB0, WPA, T, DM, 512}; pg8::StaticOrder S; S.init(T, DM, G, bx); EpiProj<0> E{SGA, M1, AB1, nullptr}; pg8::gemm_phase<EpiProj<0>, pg8::StaticOrder>(lds, g, S, E, nullptr); }
        { pg8::Gemm g{AB0 + (size_t)T * 512, WPPF, T, DM, 512}; pg8::StaticOrder S; S.init(T, DM, G, bx); EpiProj<1> E{SGP, M1, AB1, BIASF}; pg8::gemm_phase<EpiProj<1>, pg8::StaticOrder>(lds, g, S, E, nullptr); }
    }
    SEAM(6);
    if (IN(7)) { pg8::Gemm g{AB1, WOUT, T, DM, DM}; pg8::StaticOrder S; S.init(T, DM, G, bx); EpiRes<7> E{x, out, ws}; pg8::gemm_phase<EpiRes<7>, pg8::StaticOrder>(lds, g, S, E, nullptr); }
    SEAM(7);
    if (IN(8)) { pg8::Gemm g{AB0, W13B, T, NUP, DM}; pg8::StaticOrder S; S.init(T, NUP, G, bx); EpiUp E{Gb, SS}; pg8::gemm_phase<EpiUp, pg8::StaticOrder>(lds, g, S, E, nullptr); }
    SEAM(8);
    if (IN(9)) { pg8::Gemm g{Gb, W2B, T, DM, FF}; pg8::StaticOrder S; S.init(T, DM, G, bx); EpiRes<9> E{x, out, ws}; pg8::gemm_phase<EpiRes<9>, pg8::StaticOrder>(lds, g, S, E, nullptr); }
#undef IN
#undef SEAM
}

extern "C" void kernel_launch(void* const* d_in, const int* in_sizes, int n_in, void* d_out, int out_size, void* d_ws, size_t ws_size, hipStream_t stream) {
    static int grid = 0;
    if (grid == 0) {
        if (n_in != 20 || out_size != T * DM || ws_size < WS_END) { fprintf(stderr, "kernel_launch: unexpected shapes (n_in %d out %d ws %zu need %zu)\n", n_in, out_size, ws_size, (size_t)WS_END); grid = -1; return; }
        int dev = 0, cus = 0, per_cu = 0;
        (void)hipGetDevice(&dev); (void)hipDeviceGetAttribute(&cus, hipDeviceAttributeMultiprocessorCount, dev);
        if (hipFuncSetAttribute((const void*)fwd_kernel, hipFuncAttributeMaxDynamicSharedMemorySize, LDS_BYTES) != hipSuccess) { fprintf(stderr, "kernel_launch: hipFuncSetAttribute failed\n"); grid = -1; return; }
        if (hipOccupancyMaxActiveBlocksPerMultiprocessor(&per_cu, (const void*)fwd_kernel, 512, LDS_BYTES) != hipSuccess || per_cu < 1) per_cu = 1;
        (void)hipGetLastError();
        grid = cus * 1;
        fprintf(stderr, "kernel_launch: grid %d (per_cu query %d)\n", grid, per_cu);
    }
    if (grid < 0) return;
    Args a{};
    for (int i = 0; i < 20; ++i) a.in[i] = d_in[i];
    a.out = (float*)d_out; a.ws = (unsigned char*)d_ws;
#if MK_N_LAUNCHES == 1
    a.ph_lo = 0; a.ph_hi = NPHASE;
    void* args[] = {&a};
    const hipError_t e = hipLaunchCooperativeKernel((const void*)fwd_kernel, dim3(grid), dim3(512), args, LDS_BYTES, stream);
    if (e != hipSuccess) fprintf(stderr, "kernel_launch: cooperative launch failed: %s\n", hipGetErrorString(e));
#else
    for (int p = 0; p < NPHASE; ++p) { a.ph_lo = p; a.ph_hi = p + 1; hipLaunchKernelGGL(fwd_kernel, dim3(grid), dim3(512), LDS_BYTES, stream, a); }
#endif
}
```

```cpp
#include <hip/hip_runtime.h>
#include <hip/hip_cooperative_groups.h>
#include <cstdio>
namespace cg = cooperative_groups;
namespace pg8 {
#define PG8_LAS __attribute__((address_space(3)))
typedef unsigned short bf16_t;
typedef short bf16x8 __attribute__((ext_vector_type(8)));
typedef float f32x4 __attribute__((ext_vector_type(4)));
typedef unsigned u32x4 __attribute__((ext_vector_type(4)));
constexpr int BM = 256, BK = 64, HALF = 128, HTB = HALF * BK * 2  , STAGE_BYTES = 8 * HTB, NXCD = 8, WGM = 8;

__host__ __device__ __forceinline__ int lds_byte(int r, int c) { const int st = (r >> 4) * 2 + (c >> 5), rr = r & 15, cc = c & 31, ob = rr * 64 + cc * 2; return st * 1024 + (ob ^ (((ob >> 9) & 1) << 5)); }
__host__ __device__ __forceinline__ void stage_rc(int b, int& R, int& C) { const int st = b / 1024, sb = b % 1024, swz = sb ^ (((sb >> 9) & 1) << 5); R = (st >> 1) * 16 + swz / 64; C = (st & 1) * 32 + (swz % 64) / 2; }
__host__ __device__ __forceinline__ int perm32(int rho) { const int n = rho >> 4, i = rho & 15; return 8 * (i >> 2) + 4 * n + (i & 3); }

struct Unit { int pm, pn; };
struct Gemm { const bf16_t* A; const bf16_t* Bt; int M, N, K; };

struct StaticOrder {
    int nM, nN, nwg, G, c;
    __host__ __device__ void init(int M, int N, int G_, int c_) { nM = M / BM; nN = N / BM; nwg = nM * nN; G = G_; c = c_; }
    __host__ __device__ bool next(int i, Unit& u) const {
        const long L = (long)i * G + c; if (L >= nwg) return false;
        int wgid = (int)L; { const int q = nwg / NXCD, r = nwg % NXCD, xcd = wgid % NXCD, off = wgid / NXCD; wgid = (xcd < r ? xcd * (q + 1) : r * (q + 1) + (xcd - r) * q) + off; }
        const int nig = WGM * nN, gid = wgid / nig, fm = gid * WGM, gsz = (nM - fm) < WGM ? (nM - fm) : WGM;
        u.pm = fm + ((wgid % nig) % gsz); u.pn = (wgid % nig) / gsz; return true;
    }
    __device__ __forceinline__ void a_ready(const Unit&) const {}
    __device__ __forceinline__ void done(const Unit&) const {}
};
__device__ __forceinline__ unsigned cvt_pk_bf16(float lo, float hi) { unsigned r; asm volatile("s_nop 1\n\tv_cvt_pk_bf16_f32 %0, %1, %2" : "=v"(r) : "v"(lo), "v"(hi)); return r; }
template <class Epi, class Sched, bool STAMP = false>
__device__ __forceinline__ void gemm_phase(PG8_LAS unsigned char* lds, const Gemm g, const Sched& S, const Epi& E, unsigned long long* stamps) {
    const int tid = threadIdx.x, wid = __builtin_amdgcn_readfirstlane(tid >> 6), lane = tid & 63, wr = wid >> 2, wc = wid & 3, fr = lane & 15, fq = lane >> 4;
    const int K = g.K, nt = K / BK;
    int ts_lo = 0, ts_hi = 0, nts = 0; const unsigned long long rt_entry = STAMP ? (unsigned long long)wall_clock64() : 0ull;
#define PG8_STAMP() do { if (STAMP && wid == 0 && nts < 64) { const unsigned long long _c = (unsigned long long)clock64(); \
        ts_lo = (lane == nts) ? (int)(unsigned)_c : ts_lo; ts_hi = (lane == nts) ? (int)(unsigned)(_c >> 32) : ts_hi; ++nts; } } while (0)
    PG8_STAMP();
    unsigned voffA[2], voffB[2];
#pragma unroll
    for (int i = 0; i < 2; ++i) { int R, C; stage_rc(tid * 16 + i * 8192, R, C); const int Rb = Epi::PERM ? ((R & ~31) + perm32(R & 31)) : R;
        voffA[i] = (unsigned)(R * K + C) * 2u; voffB[i] = (unsigned)(Rb * K + C) * 2u; }
    const size_t kstep = (size_t)(BK * 2);
    const size_t hstep = (size_t)HALF * K * 2;
    const size_t tstep = 2 * hstep;
    const unsigned ldsw = (unsigned)wid * 1024u;
    const int aoff = lds_byte(wr * 64 + fr, fq * 8), boff = lds_byte(wc * 32 + fr, fq * 8);
#define PG8_SA(b, h) (((b) * 2 + (h)) * HTB)
#define PG8_SB(b, h) ((4 + (b) * 2 + (h)) * HTB)
#define PG8_STAGE(bufoff, gbase, voff) do { _Pragma("unroll") for (int _i = 0; _i < 2; ++_i) \
        __builtin_amdgcn_global_load_lds((const unsigned*)((const char*)(gbase) + (voff)[_i]), (PG8_LAS unsigned*)(lds + (bufoff) + ldsw + _i * 8192), 16, 0, 0); } while (0)
#define PG8_LDA(dst, b, h) do { _Pragma("unroll") for (int m = 0; m < 4; ++m) _Pragma("unroll") for (int k = 0; k < 2; ++k) dst[m][k] = *(const PG8_LAS bf16x8*)(lds + PG8_SA(b, h) + aoff + m * 2048 + k * 1024); } while (0)
#define PG8_LDB(dst, b, h) do { _Pragma("unroll") for (int n = 0; n < 2; ++n) _Pragma("unroll") for (int k = 0; k < 2; ++k) dst[n][k] = *(const PG8_LAS bf16x8*)(lds + PG8_SB(b, h) + boff + n * 2048 + k * 1024); } while (0)
#define PG8_MMA(ai, bj, At, Bt) do { __builtin_amdgcn_s_setprio(1); _Pragma("unroll") for (int m = 0; m < 4; ++m) _Pragma("unroll") for (int n = 0; n < 2; ++n) _Pragma("unroll") for (int k = 0; k < 2; ++k) \
        acc[ai][bj][m][n] = __builtin_amdgcn_mfma_f32_16x16x32_bf16(Bt[n][k], At[m][k], acc[ai][bj][m][n], 0, 0, 0); __builtin_amdgcn_s_setprio(0); } while (0)
#define PG8_WAIT_V(n) asm volatile("s_waitcnt vmcnt(" #n ")" ::: "memory")
#define PG8_WAIT_L(n) asm volatile("s_waitcnt lgkmcnt(" #n ")" ::: "memory")
#define PG8_BAR __builtin_amdgcn_s_barrier()
#define PG8_SCHED __builtin_amdgcn_sched_barrier(0)
    Unit cur, nxt; int ui = 0;
    if (!S.next(0, cur)) return;
    f32x4 acc[2][2][4][2];
#pragma unroll
    for (int a = 0; a < 2; ++a)
#pragma unroll
        for (int b = 0; b < 2; ++b)
#pragma unroll
            for (int m = 0; m < 4; ++m)
#pragma unroll
                for (int n = 0; n < 2; ++n) acc[a][b][m][n] = (f32x4){0.f, 0.f, 0.f, 0.f};
    bf16x8 At[4][2], B0[2][2], B1[2][2];
    const char* cA = (const char*)g.A + (size_t)cur.pm * tstep; const char* cB = (const char*)g.Bt + (size_t)cur.pn * tstep;
    S.a_ready(cur);
    PG8_STAGE(PG8_SB(0, 0), cB, voffB); PG8_STAGE(PG8_SA(0, 0), cA, voffA); PG8_STAGE(PG8_SB(0, 1), cB + hstep, voffB); PG8_STAGE(PG8_SA(0, 1), cA + hstep, voffA);
    if (wr == 1) PG8_BAR;
    PG8_WAIT_V(4); PG8_BAR;
    PG8_STAGE(PG8_SB(1, 0), cB + kstep, voffB); PG8_STAGE(PG8_SA(1, 0), cA + kstep, voffA); PG8_STAGE(PG8_SB(1, 1), cB + hstep + kstep, voffB);
    PG8_WAIT_V(6); PG8_BAR;
    PG8_STAMP();
    for (;;) {
        const bool has_next = S.next(ui + 1, nxt);
        const char* nA = has_next ? (const char*)g.A + (size_t)nxt.pm * tstep : cA; const char* nB = has_next ? (const char*)g.Bt + (size_t)nxt.pn * tstep : cB;
        for (int t = 0; t < nt; t += 2) {
            const bool last = (t == nt - 2);
            const char* a1 = cA + (size_t)(t + 1) * kstep;
            const char* a2 = last ? nA : cA + (size_t)(t + 2) * kstep; const char* b2 = last ? nB : cB + (size_t)(t + 2) * kstep;
            const char* a3 = a2 + kstep; const char* b3 = b2 + kstep;
            if (last && has_next) S.a_ready(nxt);
            PG8_LDB(B0, 0, 0); PG8_SCHED; PG8_LDA(At, 0, 0); PG8_STAGE(PG8_SA(1, 1), a1 + hstep, voffA);
            PG8_WAIT_L(8); PG8_BAR; PG8_WAIT_L(0); PG8_MMA(0, 0, At, B0); PG8_BAR; PG8_SCHED;
            PG8_LDB(B1, 0, 1); PG8_STAGE(PG8_SB(0, 0), b2, voffB);
            PG8_BAR; PG8_WAIT_L(0); PG8_MMA(0, 1, At, B1); PG8_BAR;
            PG8_LDA(At, 0, 1); PG8_STAGE(PG8_SA(0, 0), a2, voffA);
            PG8_BAR; PG8_WAIT_L(0); PG8_MMA(1, 0, At, B0); PG8_BAR; PG8_SCHED;
            PG8_STAGE(PG8_SB(0, 1), b2 + hstep, voffB);
            PG8_WAIT_V(6); PG8_BAR; PG8_MMA(1, 1, At, B1); PG8_BAR;
            PG8_LDB(B0, 1, 0); PG8_SCHED; PG8_LDA(At, 1, 0); PG8_STAGE(PG8_SA(0, 1), a2 + hstep, voffA);
            PG8_WAIT_L(8); PG8_BAR; PG8_WAIT_L(0); PG8_MMA(0, 0, At, B0); PG8_BAR; PG8_SCHED;
            PG8_LDB(B1, 1, 1); PG8_STAGE(PG8_SB(1, 0), b3, voffB);
            PG8_BAR; PG8_WAIT_L(0); PG8_MMA(0, 1, At, B1); PG8_BAR;
            PG8_LDA(At, 1, 1); PG8_STAGE(PG8_SA(1, 0), a3, voffA);
            PG8_BAR; PG8_WAIT_L(0); PG8_MMA(1, 0, At, B0); PG8_BAR; PG8_SCHED;
            PG8_STAGE(PG8_SB(1, 1), b3 + hstep, voffB);
            PG8_WAIT_V(6); PG8_BAR; PG8_MMA(1, 1, At, B1); PG8_BAR;
        }
        PG8_STAMP();
        if constexpr (!Epi::AFTER_DRAIN) { E(acc, cur, wr, wc, fr, fq); S.done(cur); }
        PG8_STAMP();
        if (!has_next) break;
#pragma unroll
        for (int a = 0; a < 2; ++a)
#pragma unroll
            for (int b = 0; b < 2; ++b)
#pragma unroll
                for (int m = 0; m < 4; ++m)
#pragma unroll
                    for (int n = 0; n < 2; ++n) acc[a][b][m][n] = (f32x4){0.f, 0.f, 0.f, 0.f};
        cur = nxt; cA = nA; cB = nB; ++ui;
    }
    PG8_WAIT_V(0);
    if (wr == 0) PG8_BAR;
    PG8_BAR;
    if constexpr (Epi::AFTER_DRAIN) { E.fused(acc, cur, wr, wc, fr, fq, lds, wid, lane); S.done(cur); }
    PG8_STAMP();
    if (STAMP && wid == 0) { stamps[lane] = lane < nts ? (((unsigned long long)(unsigned)ts_hi << 32) | (unsigned)ts_lo) : 0ull;
        if (lane == 62) stamps[62] = rt_entry; if (lane == 63) stamps[63] = (unsigned long long)wall_clock64(); }
#undef PG8_STAMP
#undef PG8_SA
#undef PG8_SB
#undef PG8_STAGE
#undef PG8_LDA
#undef PG8_LDB
#undef PG8_MMA
#undef PG8_WAIT_V
#undef PG8_WAIT_L
#undef PG8_BAR
#undef PG8_SCHED
}
}

#define LAS __attribute__((address_space(3)))
typedef unsigned short bf16_t;
typedef pg8::bf16x8 bf16x8;
typedef pg8::f32x4 f32x4;
typedef unsigned u32x2 __attribute__((ext_vector_type(2)));
typedef unsigned u32x4 __attribute__((ext_vector_type(4)));

constexpr int NB = 8, SEQ = 2048, DM = 1024, T = NB * SEQ, FF = 2816, NUP = 2 * FF, NIN = 3840, DIN = 3784;
constexpr float EPS = 1e-6f;
constexpr int LDS_BYTES = 155648;
constexpr int SCS = 2064;
constexpr int KT_OFF = 16 * SCS * 4;
constexpr int VT_OFF = KT_OFF + 64 * 144;
static_assert(VT_OFF + 64 * 144 <= LDS_BYTES, "LDS map");

constexpr size_t OFF_W13A = 0;
constexpr size_t OFF_W2A  = OFF_W13A + (size_t)NUP * DM * 2;
constexpr size_t OFF_WIN  = OFF_W2A + (size_t)DM * FF * 2;
constexpr size_t OFF_WPOOL = OFF_WIN + (size_t)NIN * DM * 2;
constexpr size_t OFF_WPA  = OFF_WPOOL + (size_t)512 * 512 * 2;
constexpr size_t OFF_WPP  = OFF_WPA + (size_t)DM * 512 * 2;
constexpr size_t OFF_WOUT = OFF_WPP + (size_t)DM * 512 * 2;
constexpr size_t OFF_W13B = OFF_WOUT + (size_t)DM * DM * 2;
constexpr size_t OFF_W2B  = OFF_W13B + (size_t)NUP * DM * 2;
constexpr size_t OFF_ROPE = OFF_W2B + (size_t)DM * FF * 2;
constexpr size_t OFF_SS   = OFF_ROPE + (size_t)T * 32 * 4 * 2;
constexpr size_t OFF_AB0  = OFF_SS + (size_t)T * 16 * 4;
constexpr size_t OFF_AB1  = OFF_AB0 + (size_t)T * DM * 2;
constexpr size_t OFF_R    = OFF_AB1 + (size_t)T * DM * 2;
constexpr size_t OFF_SGA  = OFF_R;
constexpr size_t OFF_SGP  = OFF_SGA + (size_t)T * DM * 2;
constexpr size_t OFF_Q    = OFF_SGP + (size_t)T * DM * 2;
constexpr size_t OFF_QI   = OFF_Q + (size_t)T * 512 * 2;
constexpr size_t OFF_U    = OFF_QI + (size_t)T * 512 * 2;
constexpr size_t OFF_K    = OFF_U + (size_t)T * 512 * 4;
constexpr size_t OFF_KI   = OFF_K + (size_t)T * 64 * 2;
constexpr size_t OFF_VT   = OFF_KI + (size_t)T * 64 * 2;
constexpr size_t OFF_WI   = OFF_VT + (size_t)T * 64 * 2;
constexpr size_t OFF_BAR  = OFF_WI + (size_t)T * 8 * 4;
constexpr size_t OFF_BIASF = OFF_BAR + 16384;
constexpr size_t OFF_WPPF = OFF_BIASF + 4096;
constexpr size_t WS_END   = OFF_WPPF + (size_t)DM * 512 * 2;
constexpr size_t OFF_G    = OFF_R;
constexpr size_t OFF_M1   = OFF_Q;
static_assert(OFF_G + (size_t)T * FF * 2 <= WS_END && OFF_M1 + (size_t)T * DM * 4 <= OFF_K, "overlay map");

__constant__ float INV_FREQ[32] = {1.000000000e+00f, 7.498942614e-01f, 5.623413324e-01f, 4.216965139e-01f, 3.162277639e-01f, 2.371373773e-01f, 1.778279394e-01f, 1.333521307e-01f, 1.000000015e-01f, 7.498941571e-02f, 5.623413250e-02f, 4.216965288e-02f, 3.162277490e-02f, 2.371373773e-02f, 1.778279431e-02f, 1.333521493e-02f, 9.999999776e-03f, 7.498941850e-03f, 5.623413250e-03f, 4.216964822e-03f, 3.162277630e-03f, 2.371373586e-03f, 1.778279431e-03f, 1.333521446e-03f, 1.000000047e-03f, 7.498942432e-04f, 5.623413017e-04f, 4.216965172e-04f, 3.162277571e-04f, 2.371373703e-04f, 1.778279402e-04f, 1.333521504e-04f};

__device__ __forceinline__ float bf_lo(unsigned w) { return __uint_as_float(w << 16); }
__device__ __forceinline__ float bf_hi(unsigned w) { return __uint_as_float(w & 0xffff0000u); }
__device__ __forceinline__ u32x2 pack4(f32x4 v) { u32x2 w; w.x = pg8::cvt_pk_bf16(v[0], v[1]); w.y = pg8::cvt_pk_bf16(v[2], v[3]); return w; }
__device__ __forceinline__ float sum4(f32x4 v) { return (v[0] + v[1]) + (v[2] + v[3]); }
__device__ __forceinline__ float sigmoidf_(float x) { return __builtin_amdgcn_rcpf(1.0f + __builtin_amdgcn_exp2f(-1.44269504f * x)); }
__device__ __forceinline__ float wave_sum(float v) {
#pragma unroll
    for (int o = 1; o < 64; o <<= 1) v += __shfl_xor(v, o);
    return v;
}
__device__ __forceinline__ void row_rinv8(const float* ss, int row0, int fq, float (&rs)[2][4]) {
    f32x4 part[2][4];
#pragma unroll
    for (int ai = 0; ai < 2; ++ai)
#pragma unroll
        for (int m = 0; m < 4; ++m) part[ai][m] = *(const f32x4*)(ss + (size_t)(row0 + ai * 128 + m * 16) * 16 + 4 * fq);
#pragma unroll
    for (int ai = 0; ai < 2; ++ai)
#pragma unroll
        for (int m = 0; m < 4; ++m) { float s = sum4(part[ai][m]); s += __shfl_xor(s, 16); s += __shfl_xor(s, 32); rs[ai][m] = __builtin_amdgcn_rsqf(s * (1.0f / DM) + EPS); }
}

enum { CV_NAT = 0, CV_UP = 1, CV_IN = 2, CV_POOL = 3 };
template <int MODE>
__device__ __forceinline__ void cvt_item(const float* s0, const float* s1, int K, int nblk, bf16_t* WT, LAS float* scr, int item, int lane, const float* gk = nullptr) {
    const int kb = item / nblk, nb = item % nblk, k0 = 64 * kb, R = 32 * nb + (lane & 31);
    const float* p = s0; int ld = nblk * 32, col = R, ks0 = k0; bool valid = true;
    if (MODE == CV_UP) { const int pn = R >> 8, bj = (R >> 7) & 1, wc = (R >> 5) & 3, n = (R >> 4) & 1, fq = (R >> 2) & 3, e = R & 3; p = n ? s1 : s0; ld = FF; col = 128 * pn + 32 * wc + 8 * fq + 4 * bj + e; }
    if (MODE == CV_IN) {
        const int pn = R >> 8, rem = R & 255, bj = rem >> 7, wc = (rem >> 5) & 3; ld = DIN;
        const bool hperm = pn < 5 && !(pn == 2 && wc >= 2);
        const int j = hperm ? pg8::perm32(rem & 31) : (rem & 31);
        if (pn < 2) col = 64 * (4 * pn + wc) + 32 * bj + j;
        else if (pn == 2) {
            if (wc == 0) col = 512 + 32 * bj + j; else if (wc == 1) col = 1152 + 32 * bj + j; else if (wc == 2) col = 576 + 32 * bj + j;
            else { col = 1216 + (j & 7); valid = (bj == 0 && j < 8); }
        }
        else if (pn < 5) col = 640 + 64 * (4 * (pn - 3) + wc) + 32 * bj + j;
        else if (pn < 7) col = 1224 + 256 * (pn - 5) + rem;
        else if (pn < 11) col = 1736 + 256 * (pn - 7) + rem;
        else col = 2760 + 256 * (pn - 11) + rem;
    }
    if (MODE == CV_POOL) { const int g = R >> 7; p = s0 + g * 16384 + (R & 127) * 128; ld = 1; col = 0; valid = ((k0 >> 7) == g); ks0 = k0 & 127; }
    float tv[32];
#pragma unroll
    for (int i = 0; i < 32; ++i) { const int kk = 2 * i + (lane >> 5); tv[i] = valid ? p[(size_t)(ks0 + kk) * ld + col] : 0.f; }
#pragma unroll
    for (int i = 0; i < 32; ++i) { const int kk = 2 * i + (lane >> 5); float v_ = tv[i]; if (MODE == CV_POOL) v_ *= s1[k0 + kk]; if (gk) v_ *= gk[k0 + kk]; scr[kk * 33 + (lane & 31)] = v_; }
    asm volatile("s_waitcnt lgkmcnt(0)" ::: "memory");
    const int c = lane & 7;
#pragma unroll
    for (int j = 0; j < 4; ++j) { const int n = (lane >> 3) + 8 * j; const LAS float* s = scr + (8 * c) * 33 + n;
        u32x4 o; o.x = pg8::cvt_pk_bf16(s[0 * 33], s[1 * 33]); o.y = pg8::cvt_pk_bf16(s[2 * 33], s[3 * 33]); o.z = pg8::cvt_pk_bf16(s[4 * 33], s[5 * 33]); o.w = pg8::cvt_pk_bf16(s[6 * 33], s[7 * 33]);
        *(u32x4*)(WT + (size_t)(32 * nb + n) * K + k0 + 8 * c) = o; }
    asm volatile("s_waitcnt lgkmcnt(0)" ::: "memory");
}

typedef float f32x2 __attribute__((ext_vector_type(2)));
__device__ __forceinline__ f32x2 swiglu_pk(f32x2 a, f32x2 b) {
    const f32x2 t = a * (-1.44269504f); f32x2 e; e.x = __builtin_amdgcn_exp2f(t.x); e.y = __builtin_amdgcn_exp2f(t.y);
    const f32x2 d = e + 1.0f; f32x2 r; r.x = __builtin_amdgcn_rcpf(d.x); r.y = __builtin_amdgcn_rcpf(d.y);
    return (a * r) * b;
}
struct EpiUp {
    static constexpr bool PERM = false, AFTER_DRAIN = false;
    bf16_t* G; const float* ss;
    __device__ __forceinline__ void operator()(const f32x4 (&acc)[2][2][4][2], const pg8::Unit& u, int wr, int wc, int fr, int fq) const {
        float rs8[2][4];
        if (ss) row_rinv8(ss, u.pm * 256 + wr * 64 + fr, fq, rs8);
#pragma unroll
        for (int ai = 0; ai < 2; ++ai)
#pragma unroll
            for (int m = 0; m < 4; ++m) {
                const int r = u.pm * 256 + ai * 128 + wr * 64 + m * 16 + fr;
                const float rs = ss ? rs8[ai][m] : 1.0f;
                u32x4 w;
#pragma unroll
                for (int bj = 0; bj < 2; ++bj) {
                    const f32x4 a = acc[ai][bj][m][0], b = acc[ai][bj][m][1];
                    f32x2 a0 = {a[0], a[1]}, a1 = {a[2], a[3]}, b0 = {b[0], b[1]}, b1 = {b[2], b[3]};
                    if (ss) { a0 = a0 * rs; a1 = a1 * rs; b0 = b0 * rs; b1 = b1 * rs; }
                    const f32x2 g0 = swiglu_pk(a0, b0), g1 = swiglu_pk(a1, b1);
                    if (bj == 0) { w.x = pg8::cvt_pk_bf16(g0.x, g0.y); w.y = pg8::cvt_pk_bf16(g1.x, g1.y); } else { w.z = pg8::cvt_pk_bf16(g0.x, g0.y); w.w = pg8::cvt_pk_bf16(g1.x, g1.y); }
                }
                *(u32x4*)(G + (size_t)r * FF + u.pn * 128 + wc * 32 + 8 * fq) = w;
            }
    }
};
template <int PH> struct EpiRes {
    static constexpr bool PERM = true, AFTER_DRAIN = false;
    const float* x; float* out; unsigned char* ws;
    __device__ __forceinline__ void operator()(const f32x4 (&acc)[2][2][4][2], const pg8::Unit& u, int wr, int wc, int fr, int fq) const {
        constexpr bool RES_BF16 = PH != 2, OUT_F32 = PH == 9; constexpr float alpha = PH == 7 ? 1.0f : 0.5f;
        const float* resf = x; const bf16_t* resb = PH == 7 ? (const bf16_t*)out : (const bf16_t*)(ws + OFF_AB0);
        bf16_t* xb = PH == 2 ? (bf16_t*)out : (bf16_t*)(ws + OFF_AB0); float* ss = (float*)(ws + OFF_SS);
#pragma unroll
        for (int ai = 0; ai < 2; ++ai) {
            f32x4 r0[4][2], r1[4][2];
#pragma unroll
            for (int m = 0; m < 4; ++m)
#pragma unroll
                for (int bj = 0; bj < 2; ++bj) {
                    const size_t off = (size_t)(u.pm * 256 + ai * 128 + wr * 64 + m * 16 + fr) * DM + u.pn * 256 + bj * 128 + wc * 32 + 8 * fq;
                    if (RES_BF16) { const u32x4 w = *(const u32x4*)(resb + off); r0[m][bj] = (f32x4){bf_lo(w.x), bf_hi(w.x), bf_lo(w.y), bf_hi(w.y)}; r1[m][bj] = (f32x4){bf_lo(w.z), bf_hi(w.z), bf_lo(w.w), bf_hi(w.w)}; }
                    else { r0[m][bj] = *(const f32x4*)(resf + off); r1[m][bj] = *(const f32x4*)(resf + off + 4); }
                }
#pragma unroll
            for (int m = 0; m < 4; ++m) {
                const int r = u.pm * 256 + ai * 128 + wr * 64 + m * 16 + fr; float sq = 0.f;
#pragma unroll
                for (int bj = 0; bj < 2; ++bj) {
                    const size_t off = (size_t)r * DM + u.pn * 256 + bj * 128 + wc * 32 + 8 * fq;
                    const f32x4 o0 = r0[m][bj] + acc[ai][bj][m][0] * alpha, o1 = r1[m][bj] + acc[ai][bj][m][1] * alpha;
                    if (OUT_F32) { *(f32x4*)(out + off) = o0; *(f32x4*)(out + off + 4) = o1; }
                    else { sq += ((o0[0] * o0[0] + o0[1] * o0[1]) + (o0[2] * o0[2] + o0[3] * o0[3])) + ((o1[0] * o1[0] + o1[1] * o1[1]) + (o1[2] * o1[2] + o1[3] * o1[3]));
                           const u32x2 p0 = pack4(o0), p1 = pack4(o1); u32x4 w; w.x = p0.x; w.y = p0.y; w.z = p1.x; w.w = p1.y; *(u32x4*)(xb + off) = w; }
                }
                if (!OUT_F32) { sq += __shfl_xor(sq, 16); sq += __shfl_xor(sq, 32); if (fq == 0) ss[(size_t)r * 16 + u.pn * 4 + wc] = sq; }
            }
        }
    }
};
struct EpiIn {
    static constexpr bool PERM = false, AFTER_DRAIN = false;
    const float* ss; const float* cs; const float* sn; const float* qn; const float* kn;
    bf16_t *Q, *QI, *K, *KI, *VT; float *WI, *U; bf16_t *SGA, *SGP;
    __device__ __forceinline__ void operator()(const f32x4 (&acc)[2][2][4][2], const pg8::Unit& u, int wr, int wc, int fr, int fq) const {
        const int pn = u.pn;
        float rs8[2][4];
        row_rinv8(ss, u.pm * 256 + wr * 64 + fr, fq, rs8);
        const bool norm_unit = pn < 2 || (pn == 2 && wc == 0);
        f32x4 gain[2][2];
#pragma unroll
        for (int bj = 0; bj < 2; ++bj)
#pragma unroll
            for (int n = 0; n < 2; ++n) gain[bj][n] = norm_unit ? *(const f32x4*)((pn < 2 ? qn : kn) + 32 * bj + 8 * fq + 4 * n) : (f32x4){1.f, 1.f, 1.f, 1.f};
#pragma unroll
        for (int ai = 0; ai < 2; ++ai)
#pragma unroll
            for (int m = 0; m < 4; ++m) {
                const int r = u.pm * 256 + ai * 128 + wr * 64 + m * 16 + fr;
                const float rs = rs8[ai][m];
                f32x4 v[2][2];
#pragma unroll
                for (int bj = 0; bj < 2; ++bj)
#pragma unroll
                    for (int n = 0; n < 2; ++n) v[bj][n] = acc[ai][bj][m][n] * rs;
                if (pn < 5) {
                    const bool is_q = pn < 2, is_misc = pn == 2;
                    const bool do_norm = is_q || (is_misc && wc == 0), do_rope = !(is_misc && wc >= 2);
                    if (do_norm) {
                        float sq = 0.f;
#pragma unroll
                        for (int bj = 0; bj < 2; ++bj)
#pragma unroll
                            for (int n = 0; n < 2; ++n) sq += (v[bj][n][0] * v[bj][n][0] + v[bj][n][1] * v[bj][n][1]) + (v[bj][n][2] * v[bj][n][2] + v[bj][n][3] * v[bj][n][3]);
                        sq += __shfl_xor(sq, 16); sq += __shfl_xor(sq, 32);
                        const float rn = __builtin_amdgcn_rsqf(sq * (1.0f / 64.0f) + EPS);
#pragma unroll
                        for (int bj = 0; bj < 2; ++bj)
#pragma unroll
                            for (int n = 0; n < 2; ++n) v[bj][n] = v[bj][n] * rn * gain[bj][n];
                    }
                    if (do_rope) {
#pragma unroll
                        for (int n = 0; n < 2; ++n) {
                            const f32x4 c4 = *(const f32x4*)(cs + (size_t)r * 32 + 8 * fq + 4 * n), s4 = *(const f32x4*)(sn + (size_t)r * 32 + 8 * fq + 4 * n);
                            const f32x4 x1 = v[0][n], x2 = v[1][n];
                            v[0][n] = x1 * c4 - x2 * s4; v[1][n] = x2 * c4 + x1 * s4;
                        }
                    }
                    if (is_misc && wc == 2) {
                        const int b = r / SEQ, s = r % SEQ;
#pragma unroll
                        for (int bj = 0; bj < 2; ++bj)
#pragma unroll
                            for (int n = 0; n < 2; ++n)
#pragma unroll
                                for (int e = 0; e < 4; ++e) { const int d = 32 * bj + 16 * n + 4 * fq + e; VT[((size_t)b * 64 + d) * SEQ + s] = (bf16_t)(pg8::cvt_pk_bf16(v[bj][n][e], 0.f) & 0xffffu); }
                    } else if (is_misc && wc == 3) {
                        if (fq < 2) *(f32x4*)(WI + (size_t)r * 8 + 4 * fq) = v[0][0];
                    } else {
                        bf16_t* dst;
                        if (is_q) dst = Q + ((size_t)r * 8 + 4 * pn + wc) * 64;
                        else if (is_misc) dst = (wc == 0 ? K : KI) + (size_t)r * 64;
                        else dst = QI + ((size_t)r * 8 + 4 * (pn - 3) + wc) * 64;
#pragma unroll
                        for (int bj = 0; bj < 2; ++bj) { const u32x2 p0 = pack4(v[bj][0]), p1 = pack4(v[bj][1]); u32x4 w; w.x = p0.x; w.y = p0.y; w.z = p1.x; w.w = p1.y; *(u32x4*)(dst + 32 * bj + 8 * fq) = w; }
                    }
                } else if (pn < 7) {
#pragma unroll
                    for (int bj = 0; bj < 2; ++bj)
#pragma unroll
                        for (int n = 0; n < 2; ++n) *(f32x4*)(U + (size_t)r * 512 + 256 * (pn - 5) + 128 * bj + 32 * wc + 16 * n + 4 * fq) = v[bj][n];
                } else {
                    bf16_t* dst = (pn < 11) ? SGA + (size_t)r * DM + 256 * (pn - 7) : SGP + (size_t)r * DM + 256 * (pn - 11);
#pragma unroll
                    for (int bj = 0; bj < 2; ++bj)
#pragma unroll
                        for (int n = 0; n < 2; ++n) { f32x4 g;
#pragma unroll
                            for (int e = 0; e < 4; ++e) g[e] = sigmoidf_(v[bj][n][e]);
                            *(u32x2*)(dst + 128 * bj + 32 * wc + 16 * n + 4 * fq) = pack4(g); }
                }
            }
    }
};
struct EpiPlain {
    static constexpr bool PERM = false, AFTER_DRAIN = false;
    bf16_t* O; int ldo;
    __device__ __forceinline__ void operator()(const f32x4 (&acc)[2][2][4][2], const pg8::Unit& u, int wr, int wc, int fr, int fq) const {
#pragma unroll
        for (int ai = 0; ai < 2; ++ai)
#pragma unroll
            for (int m = 0; m < 4; ++m)
#pragma unroll
                for (int bj = 0; bj < 2; ++bj)
#pragma unroll
                    for (int n = 0; n < 2; ++n)
                        *(u32x2*)(O + (size_t)(u.pm * 256 + ai * 128 + wr * 64 + m * 16 + fr) * ldo + u.pn * 256 + bj * 128 + wc * 32 + n * 16 + 4 * fq) = pack4(acc[ai][bj][m][n]);
    }
};
template <int STEP> struct EpiProj {
    static constexpr bool PERM = true, AFTER_DRAIN = false;
    const bf16_t* SG; bf16_t* M1; bf16_t* MG; const float* bias;
    __device__ __forceinline__ void operator()(const f32x4 (&acc)[2][2][4][2], const pg8::Unit& u, int wr, int wc, int fr, int fq) const {
        f32x4 b0[2], b1[2];
#pragma unroll
        for (int bj = 0; bj < 2; ++bj) { const int c = u.pn * 256 + bj * 128 + wc * 32 + 8 * fq; b0[bj] = (f32x4){0.f, 0.f, 0.f, 0.f}; b1[bj] = b0[bj]; if (STEP == 1) { b0[bj] = *(const f32x4*)(bias + c); b1[bj] = *(const f32x4*)(bias + c + 4); } }
#pragma unroll
        for (int ai = 0; ai < 2; ++ai) {
            u32x4 gw[4][2], mw[4][2];
#pragma unroll
            for (int m = 0; m < 4; ++m)
#pragma unroll
                for (int bj = 0; bj < 2; ++bj) {
                    const size_t off = (size_t)(u.pm * 256 + ai * 128 + wr * 64 + m * 16 + fr) * DM + u.pn * 256 + bj * 128 + wc * 32 + 8 * fq;
                    gw[m][bj] = *(const u32x4*)(SG + off); if (STEP == 1) mw[m][bj] = *(const u32x4*)(M1 + off);
                }
#pragma unroll
            for (int m = 0; m < 4; ++m)
#pragma unroll
                for (int bj = 0; bj < 2; ++bj) {
                    const size_t off = (size_t)(u.pm * 256 + ai * 128 + wr * 64 + m * 16 + fr) * DM + u.pn * 256 + bj * 128 + wc * 32 + 8 * fq;
                    const u32x4 g = gw[m][bj];
                    const f32x4 g0 = {bf_lo(g.x), bf_hi(g.x), bf_lo(g.y), bf_hi(g.y)}, g1 = {bf_lo(g.z), bf_hi(g.z), bf_lo(g.w), bf_hi(g.w)};
                    f32x4 o0, o1;
                    if (STEP == 0) { o0 = g0 * acc[ai][bj][m][0]; o1 = g1 * acc[ai][bj][m][1]; }
                    else { const u32x4 mm = mw[m][bj];
                           o0 = (f32x4){bf_lo(mm.x), bf_hi(mm.x), bf_lo(mm.y), bf_hi(mm.y)} + g0 * (acc[ai][bj][m][0] + b0[bj]);
                           o1 = (f32x4){bf_lo(mm.z), bf_hi(mm.z), bf_lo(mm.w), bf_hi(mm.w)} + g1 * (acc[ai][bj][m][1] + b1[bj]); }
                    const u32x2 p0 = pack4(o0), p1 = pack4(o1); u32x4 w; w.x = p0.x; w.y = p0.y; w.z = p1.x; w.w = p1.y;
                    *(u32x4*)((STEP == 0 ? M1 : MG) + off) = w;
                }
        }
    }
};

__device__ __forceinline__ int count_gt8(int c, unsigned mid, unsigned k0, unsigned k1, unsigned k2, unsigned k3, unsigned k4, unsigned k5, unsigned k6, unsigned k7) {
    unsigned long long m0, m1, m2, m3, m4, m5, m6, m7; int t0, t1;
    asm volatile("v_cmp_lt_u32_e64 %[m0], %[mid], %[k0]\n\tv_cmp_lt_u32_e64 %[m1], %[mid], %[k1]\n\tv_cmp_lt_u32_e64 %[m2], %[mid], %[k2]\n\tv_cmp_lt_u32_e64 %[m3], %[mid], %[k3]\n\t"
                 "v_cmp_lt_u32_e64 %[m4], %[mid], %[k4]\n\tv_cmp_lt_u32_e64 %[m5], %[mid], %[k5]\n\tv_cmp_lt_u32_e64 %[m6], %[mid], %[k6]\n\tv_cmp_lt_u32_e64 %[m7], %[mid], %[k7]\n\t"
                 "s_bcnt1_i32_b64 %[t0], %[m0]\n\ts_bcnt1_i32_b64 %[t1], %[m1]\n\ts_add_i32 %[c], %[c], %[t0]\n\ts_bcnt1_i32_b64 %[t0], %[m2]\n\ts_add_i32 %[c], %[c], %[t1]\n\ts_bcnt1_i32_b64 %[t1], %[m3]\n\t"
                 "s_add_i32 %[c], %[c], %[t0]\n\ts_bcnt1_i32_b64 %[t0], %[m4]\n\ts_add_i32 %[c], %[c], %[t1]\n\ts_bcnt1_i32_b64 %[t1], %[m5]\n\ts_add_i32 %[c], %[c], %[t0]\n\ts_bcnt1_i32_b64 %[t0], %[m6]\n\t"
                 "s_add_i32 %[c], %[c], %[t1]\n\ts_bcnt1_i32_b64 %[t1], %[m7]\n\ts_add_i32 %[c], %[c], %[t0]\n\ts_add_i32 %[c], %[c], %[t1]"
                 : [c] "+s"(c), [m0] "=&s"(m0), [m1] "=&s"(m1), [m2] "=&s"(m2), [m3] "=&s"(m3), [m4] "=&s"(m4), [m5] "=&s"(m5), [m6] "=&s"(m6), [m7] "=&s"(m7), [t0] "=&s"(t0), [t1] "=&s"(t1)
                 : [mid] "s"(mid), [k0] "v"(k0), [k1] "v"(k1), [k2] "v"(k2), [k3] "v"(k3), [k4] "v"(k4), [k5] "v"(k5), [k6] "v"(k6), [k7] "v"(k7)
                 : "scc");
    return c;
}
__device__ __forceinline__ unsigned ord_key(float v) { const unsigned b = __float_as_uint(v); return (b & 0x80000000u) ? ~b : (b | 0x80000000u); }

__device__ __forceinline__ void select_row(LAS float* srow, int t, int nreg, int lane, unsigned kept) {
    LAS unsigned* mrow = (LAS unsigned*)srow;
    const int ngrp = (nreg + 7) >> 3;
    unsigned ku[32];
#pragma unroll
    for (int g = 0; g < 4; ++g) {
        if (g < ngrp) {
#pragma unroll
            for (int j = 0; j < 8; ++j) { const int i = 8 * g + j, key = 64 * i + lane; const float sv = srow[key]; ku[i] = ord_key((key <= t) ? sv : -__builtin_inff()); }
        } else {
#pragma unroll
            for (int j = 0; j < 8; ++j) ku[8 * g + j] = 0x007fffffu;
        }
    }
    if (t + 1 <= 256) {
#pragma unroll
        for (int g = 0; g < 4; ++g) if (g < ngrp) {
#pragma unroll
            for (int j = 0; j < 8; ++j) { const int key = 64 * (8 * g + j) + lane; mrow[key] = (key <= t) ? kept : 0xff800000u; }
        }
        return;
    }
    unsigned lo = 0u, hi = 0xffffffffu; int chi = 0; bool exact = false;
    while (hi - lo > 1u) {
        const unsigned mid = lo + ((hi - lo) >> 1); int c = 0;
#pragma unroll
        for (int g = 0; g < 4; ++g) if (g < ngrp) {
            c = count_gt8(c, mid, ku[8 * g], ku[8 * g + 1], ku[8 * g + 2], ku[8 * g + 3], ku[8 * g + 4], ku[8 * g + 5], ku[8 * g + 6], ku[8 * g + 7]);
        }
        if (c == 256) { hi = mid; chi = c; exact = true; break; }
        if (c > 256) lo = mid; else { hi = mid; chi = c; }
    }
    int need = exact ? 0 : (256 - chi);
#pragma unroll
    for (int g = 0; g < 4; ++g) if (g < ngrp) {
#pragma unroll
        for (int j = 0; j < 8; ++j) {
            const int i = 8 * g + j; bool keep = ku[i] > hi;
            if (need > 0) {
                unsigned long long eq = __ballot(ku[i] == hi); int cnt = __popcll(eq);
                while (cnt > need) { eq &= ~(1ull << (63 - __builtin_clzll(eq))); --cnt; }
                need -= cnt; keep = keep || ((eq >> lane) & 1ull);
            }
            mrow[64 * i + lane] = keep ? kept : 0xff800000u;
        }
    }
}

struct P4Ptrs { const bf16_t *Q, *QI, *K, *KI, *VT; const float* WI; bf16_t* Y; float bc; };

__device__ __forceinline__ void p4_unit(LAS unsigned char* lds, const P4Ptrs& P, int b, int q0, int wid, int lane) {
    LAS float* sc = (LAS float*)lds;
    const int lg = lane >> 4, ln = lane & 15; const size_t tb = (size_t)b * SEQ;
    const int nstep = (q0 + 16 + 31) / 32;
    {
        bf16x8 aX[4][2], aY[4][2]; float w[4][8];
        const float idx_scale = 0.125f * 0.35355339059327373f;
#pragma unroll
        for (int g = 0; g < 4; ++g) {
            const bf16_t* pq = P.QI + ((tb + q0 + 4 * g + (ln >> 2)) * 8 + (ln & 3)) * 64 + 8 * lg;
#pragma unroll
            for (int ks = 0; ks < 2; ++ks) { aX[g][ks] = *(const bf16x8*)(pq + 32 * ks); aY[g][ks] = *(const bf16x8*)(pq + 256 + 32 * ks); }
            const f32x4* pw = (const f32x4*)(P.WI + (tb + q0 + 4 * g + lg) * 8); const f32x4 w0 = pw[0], w1 = pw[1];
#pragma unroll
            for (int e = 0; e < 4; ++e) { w[g][e] = w0[e] * idx_scale; w[g][4 + e] = w1[e] * idx_scale; }
        }
        const int ntile = q0 / 16 + 1;
        const bf16_t* pk = P.KI + (tb + 16 * wid + ln) * 64 + 8 * lg;
        bf16x8 b0n = {0, 0, 0, 0, 0, 0, 0, 0}, b1n = b0n;
        if (wid < ntile) { b0n = *(const bf16x8*)pk; b1n = *(const bf16x8*)(pk + 32); }
        for (int kt = wid; kt < ntile; kt += 8) {
            const bf16x8 b0 = b0n, b1 = b1n;
            pk += 8 * 16 * 64;
            if (kt + 8 < ntile) { b0n = *(const bf16x8*)pk; b1n = *(const bf16x8*)(pk + 32); }
#pragma unroll
            for (int g = 0; g < 4; ++g) {
                f32x4 x = {0.f, 0.f, 0.f, 0.f}, y = {0.f, 0.f, 0.f, 0.f};
                x = __builtin_amdgcn_mfma_f32_16x16x32_bf16(aX[g][0], b0, x, 0, 0, 0); x = __builtin_amdgcn_mfma_f32_16x16x32_bf16(aX[g][1], b1, x, 0, 0, 0);
                y = __builtin_amdgcn_mfma_f32_16x16x32_bf16(aY[g][0], b0, y, 0, 0, 0); y = __builtin_amdgcn_mfma_f32_16x16x32_bf16(aY[g][1], b1, y, 0, 0, 0);
                float s = 0.f;
#pragma unroll
                for (int e = 0; e < 4; ++e) { s += w[g][e] * fmaxf(x[e], 0.f); s += w[g][4 + e] * fmaxf(y[e], 0.f); }
                sc[(4 * g + lg) * SCS + 16 * kt + ln] = s;
            }
        }
    }
    __syncthreads();
    constexpr int HPW = 2, NHG = 8 / HPW, NKS = 8 / NHG, CBW = HPW * 16 + HPW; const int hg = wid / NKS, ksp = wid % NKS;
    bf16x8 qb[HPW][2];
#pragma unroll
    for (int h = 0; h < HPW; ++h) { const bf16_t* pq = P.Q + ((tb + q0 + ln) * 8 + HPW * hg + h) * 64 + 8 * lg; qb[h][0] = *(const bf16x8*)pq; qb[h][1] = *(const bf16x8*)(pq + 32); }
    const int tid = wid * 64 + lane, srow_ = tid >> 3, sch = tid & 7;
    const bf16_t* gk = P.K + (tb + srow_) * 64 + 8 * sch;
    const bf16_t* gv = P.VT + ((size_t)b * 64 + srow_) * SEQ + 8 * sch;
    u32x4 rk = *(const u32x4*)gk, rv = *(const u32x4*)gv;
    {
        const int nreg = (32 * nstep + 63) >> 6;
        const unsigned kept = __float_as_uint(-P.bc);
        select_row(sc + (2 * wid) * SCS, q0 + 2 * wid, nreg, lane, kept);
        select_row(sc + (2 * wid + 1) * SCS, q0 + 2 * wid + 1, nreg, lane, kept);
    }
    __syncthreads();
    {
        f32x4 o[HPW][4]; float ls[HPW];
#pragma unroll
        for (int h = 0; h < HPW; ++h) { ls[h] = 0.f;
#pragma unroll
            for (int dt = 0; dt < 4; ++dt) o[h][dt] = (f32x4){0.f, 0.f, 0.f, 0.f}; }
        const float cl = 0.125f * 1.44269504f;
        const LAS float* brow = (const LAS float*)sc + ln * SCS + 4 * lg;
        LAS unsigned char* lk = lds + KT_OFF + srow_ * 144 + sch * 16;
        LAS unsigned char* lv = lds + VT_OFF + srow_ * 144 + sch * 16;
        const LAS unsigned char* fk = lds + KT_OFF + (32 * ksp + ln) * 144 + 16 * lg;
        const LAS unsigned char* fv = lds + VT_OFF + ln * 144 + 64 * ksp + 8 * lg;
        const int ntile = (nstep + 1) >> 1;
        for (int tt = 0; tt < ntile; ++tt) {
            __syncthreads();
            *(LAS u32x4*)lk = rk; *(LAS u32x4*)lv = rv;
            __syncthreads();
            if (tt + 1 < ntile) { gk += 64 * 64; gv += 64; rk = *(const u32x4*)gk; rv = *(const u32x4*)gv; }
            const int st = 2 * tt + ksp;
            if (st < nstep) {
                const bf16x8 k0 = *(const LAS bf16x8*)fk, k1 = *(const LAS bf16x8*)(fk + 64), k2 = *(const LAS bf16x8*)(fk + 16 * 144), k3 = *(const LAS bf16x8*)(fk + 16 * 144 + 64);
                union { u32x4 u; bf16x8 v; } va[4];
#pragma unroll
                for (int dt = 0; dt < 4; ++dt) { const u32x2 v0 = *(const LAS u32x2*)(fv + dt * 16 * 144), v1 = *(const LAS u32x2*)(fv + dt * 16 * 144 + 32); va[dt].u.x = v0.x; va[dt].u.y = v0.y; va[dt].u.z = v1.x; va[dt].u.w = v1.y; }
                const f32x4 ba = *(const LAS f32x4*)(brow + 32 * st), bb = *(const LAS f32x4*)(brow + 32 * st + 16);
#pragma unroll
                for (int h = 0; h < HPW; ++h) {
                    f32x4 sa = {0.f, 0.f, 0.f, 0.f}, sb = {0.f, 0.f, 0.f, 0.f};
                    sa = __builtin_amdgcn_mfma_f32_16x16x32_bf16(k0, qb[h][0], sa, 0, 0, 0); sa = __builtin_amdgcn_mfma_f32_16x16x32_bf16(k1, qb[h][1], sa, 0, 0, 0);
                    sb = __builtin_amdgcn_mfma_f32_16x16x32_bf16(k2, qb[h][0], sb, 0, 0, 0); sb = __builtin_amdgcn_mfma_f32_16x16x32_bf16(k3, qb[h][1], sb, 0, 0, 0);
                    float pa[4], pb[4], ps = 0.f;
#pragma unroll
                    for (int e = 0; e < 4; ++e) { pa[e] = __builtin_amdgcn_exp2f(sa[e] * cl + ba[e]); pb[e] = __builtin_amdgcn_exp2f(sb[e] * cl + bb[e]); ps += pa[e] + pb[e]; }
                    ls[h] += ps;
                    union { u32x4 u; bf16x8 v; } p8;
                    p8.u.x = pg8::cvt_pk_bf16(pa[0], pa[1]); p8.u.y = pg8::cvt_pk_bf16(pa[2], pa[3]); p8.u.z = pg8::cvt_pk_bf16(pb[0], pb[1]); p8.u.w = pg8::cvt_pk_bf16(pb[2], pb[3]);
#pragma unroll
                    for (int dt = 0; dt < 4; ++dt) o[h][dt] = __builtin_amdgcn_mfma_f32_16x16x32_bf16(va[dt].v, p8.v, o[h][dt], 0, 0, 0);
                }
            }
        }
        __syncthreads();
        LAS float* cb = (LAS float*)lds;
        if (ksp != 0) {
            LAS float* c0 = cb + (size_t)((hg * (NKS - 1) + ksp - 1) * CBW) * 64 + lane;
#pragma unroll
            for (int h = 0; h < HPW; ++h) {
#pragma unroll
                for (int dt = 0; dt < 4; ++dt)
#pragma unroll
                    for (int e = 0; e < 4; ++e) c0[((h * 4 + dt) * 4 + e) * 64] = o[h][dt][e];
                c0[(HPW * 16 + h) * 64] = ls[h];
            }
        }
        __syncthreads();
        if (ksp == 0) {
#pragma unroll
            for (int j = 0; j < NKS - 1; ++j) {
                const LAS float* c0 = cb + (size_t)((hg * (NKS - 1) + j) * CBW) * 64 + lane;
#pragma unroll
                for (int h = 0; h < HPW; ++h) {
#pragma unroll
                    for (int dt = 0; dt < 4; ++dt)
#pragma unroll
                        for (int e = 0; e < 4; ++e) o[h][dt][e] += c0[((h * 4 + dt) * 4 + e) * 64];
                    ls[h] += c0[(HPW * 16 + h) * 64];
                }
            }
#pragma unroll
            for (int h = 0; h < HPW; ++h) {
                float l = ls[h]; l += __shfl_xor(l, 16); l += __shfl_xor(l, 32);
                const float inv = 1.0f / l;
                bf16_t* py = P.Y + (tb + q0 + ln) * 512 + (HPW * hg + h) * 64 + 4 * lg;
#pragma unroll
                for (int dt = 0; dt < 4; ++dt) *(u32x2*)(py + 16 * dt) = pack4(o[h][dt] * inv);
            }
        }
    }
    __syncthreads();
}

__device__ __forceinline__ void fold_bias(const float* pb, const float* psc, const float* pp, float* BIASF, int tidx, int nthr) {
    for (int o = tidx; o < DM * 16; o += nthr) {
        const int n = o >> 4, kp = o & 15; float acc = 0.f;
#pragma unroll 8
        for (int j = 0; j < 32; ++j) { const int k = 32 * kp + j; acc += (pb[k] * psc[k]) * pp[(size_t)k * DM + n]; }
        acc += __shfl_xor(acc, 1); acc += __shfl_xor(acc, 2); acc += __shfl_xor(acc, 4); acc += __shfl_xor(acc, 8);
        if (kp == 0) BIASF[n] = acc;
    }
}

#define XB_TMO      128
#define XB_XCNT(j)  (256  + 64 * (j))
#define XB_XSUB(j)  (1280 + 64 * (j))
#define XB_XGEN(j)  (2304 + 64 * (j))
#define XB_TOP      3328
#define XB_TOPGEN   3392
#define XCD_BAR_WORDS 3456
#define XB_SPIN_CAP (1u << 18)

__device__ __forceinline__ unsigned xb_ld(unsigned* p)              { return __hip_atomic_load(p, __ATOMIC_RELAXED, __HIP_MEMORY_SCOPE_AGENT); }
__device__ __forceinline__ unsigned xb_add(unsigned* p, unsigned v) { return __hip_atomic_fetch_add(p, v, __ATOMIC_RELAXED, __HIP_MEMORY_SCOPE_AGENT); }
__device__ __forceinline__ unsigned xb_xcc_id() { return (unsigned)__builtin_amdgcn_s_getreg((3 << 11) | 20) & 0xFu; }
#define XB_SPIN(cond, bar) do { unsigned _sp = 0; while (cond) { __builtin_amdgcn_s_sleep(1); \
    if ((++_sp & 255u) == 0u) { if (xb_ld(&(bar)[XB_TMO])) break; if (_sp > XB_SPIN_CAP) { atomicAdd(&(bar)[XB_TMO], 1u); break; } } } } while (0)

struct XcdBarrier {
    unsigned* bar; unsigned x;
    volatile LAS unsigned* st;
};

__device__ __forceinline__ XcdBarrier xcd_barrier_post(unsigned* bar, volatile LAS unsigned* st) {
    XcdBarrier b; b.bar = bar; b.x = xb_xcc_id(); b.st = st;
    if (threadIdx.x == 0) (void)xb_add(&bar[XB_XCNT(b.x)], 1u);
    return b;
}
__device__ __forceinline__ void xcd_barrier_complete(unsigned* bar, unsigned x, unsigned& nloc, unsigned& nx) {
    const unsigned G = gridDim.x * gridDim.y * gridDim.z;
    unsigned sum, cnt, mine, sp = 0u;
    for (;;) {
        sum = 0u; cnt = 0u; mine = 0u;
#pragma unroll
        for (unsigned j = 0; j < 16; ++j) { const unsigned c = xb_ld(&bar[XB_XCNT(j)]); sum += c; cnt += (c > 0u) ? 1u : 0u; mine = (j == x) ? c : mine; }
        if (sum == G) break;
        __builtin_amdgcn_s_sleep(1);
        if ((++sp & 255u) == 0u) { if (xb_ld(&bar[XB_TMO])) break; if (sp > XB_SPIN_CAP) { atomicAdd(&bar[XB_TMO], 1u); break; } }
    }
    nloc = mine > 0u ? mine : 1u; nx = cnt > 0u ? cnt : 1u;
}

__device__ __forceinline__ void xcd_barrier(const XcdBarrier& b) {
    asm volatile("s_waitcnt vmcnt(0)" ::: "memory");
    __syncthreads();
    if (threadIdx.x == 0) {
        unsigned* bar = b.bar;
        __builtin_amdgcn_s_waitcnt(0);
        unsigned nloc = b.st[0], nx = b.st[1];
        if (nloc == 0u) { xcd_barrier_complete(bar, b.x, nloc, nx); b.st[0] = nloc; b.st[1] = nx; }
        const unsigned old = xb_add(&bar[XB_XSUB(b.x)], 1u);
        const unsigned gen = old / nloc;
        if (old + 1u == (gen + 1u) * nloc) {
            __builtin_amdgcn_fence(__ATOMIC_RELEASE, "agent");
            asm volatile("s_waitcnt vmcnt(0)" ::: "memory");
            const unsigned og = xb_add(&bar[XB_TOP], 1u);
            const unsigned tg = og / nx;
            if (og + 1u == (tg + 1u) * nx) xb_add(&bar[XB_TOPGEN], 1u);
            else XB_SPIN(xb_ld(&bar[XB_TOPGEN]) == tg, bar);
            __builtin_amdgcn_fence(__ATOMIC_ACQUIRE, "agent");
            xb_add(&bar[XB_XGEN(b.x)], 1u);
            asm volatile("s_waitcnt vmcnt(0)" ::: "memory");
        } else {
            XB_SPIN(xb_ld(&bar[XB_XGEN(b.x)]) == gen, bar);
            __builtin_amdgcn_fence(__ATOMIC_ACQUIRE, "agent");
            asm volatile("s_waitcnt vmcnt(0)" ::: "memory");
        }
    }
    __syncthreads();
}

struct Args { const void* in[20]; float* out; unsigned char* ws; int ph_lo, ph_hi; };
#ifndef MK_N_LAUNCHES
#define MK_N_LAUNCHES 1
#endif
constexpr int NPHASE = 10;

__global__ void __launch_bounds__(512) fwd_kernel(Args a) {
    extern __shared__ __attribute__((aligned(16))) unsigned char lds_raw[];
    LAS unsigned char* lds = (LAS unsigned char*)lds_raw;
    const int tid = threadIdx.x, lane = tid & 63, wid = __builtin_amdgcn_readfirstlane(tid >> 6);
    const int G = gridDim.x, bx = blockIdx.x;
    const int lo = a.ph_lo, hi = a.ph_hi;
    unsigned char* ws = a.ws;
    const float* x = (const float*)a.in[0]; const int* positions = (const int*)a.in[1];
    float* out = a.out;
    bf16_t* W13A = (bf16_t*)(ws + OFF_W13A); bf16_t* W2A = (bf16_t*)(ws + OFF_W2A); bf16_t* WIN = (bf16_t*)(ws + OFF_WIN); bf16_t* WPOOL = (bf16_t*)(ws + OFF_WPOOL);
    bf16_t* WPA = (bf16_t*)(ws + OFF_WPA); bf16_t* WPP = (bf16_t*)(ws + OFF_WPP); bf16_t* WOUT = (bf16_t*)(ws + OFF_WOUT); bf16_t* W13B = (bf16_t*)(ws + OFF_W13B); bf16_t* W2B = (bf16_t*)(ws + OFF_W2B);
    float* CS = (float*)(ws + OFF_ROPE); float* SN = CS + (size_t)T * 32; float* SS = (float*)(ws + OFF_SS);
    bf16_t* AB0 = (bf16_t*)(ws + OFF_AB0); bf16_t* AB1 = (bf16_t*)(ws + OFF_AB1);
    bf16_t* SGA = (bf16_t*)(ws + OFF_SGA); bf16_t* SGP = (bf16_t*)(ws + OFF_SGP); bf16_t* Qb = (bf16_t*)(ws + OFF_Q); bf16_t* QIb = (bf16_t*)(ws + OFF_QI);
    float* Ub = (float*)(ws + OFF_U); bf16_t* Kb = (bf16_t*)(ws + OFF_K); bf16_t* KIb = (bf16_t*)(ws + OFF_KI); bf16_t* VTb = (bf16_t*)(ws + OFF_VT); float* WIb = (float*)(ws + OFF_WI);
    bf16_t* Gb = (bf16_t*)(ws + OFF_G); bf16_t* M1 = (bf16_t*)(ws + OFF_M1); float* BIASF = (float*)(ws + OFF_BIASF); bf16_t* WPPF = (bf16_t*)(ws + OFF_WPPF);
#if MK_N_LAUNCHES == 1
    cg::grid_group grid = cg::this_grid();
    if (tid < 4) ((LAS unsigned*)(lds + LDS_BYTES - 16))[tid] = 0u;
    __syncthreads();
    if (hi > NPHASE) grid.sync();
    const XcdBarrier xbar = xcd_barrier_post((unsigned*)(ws + OFF_BAR), (volatile LAS unsigned*)(lds + LDS_BYTES - 16));
#define SEAM(k) do { if (lo <= (k) && (k) + 1 < hi) xcd_barrier(xbar); } while (0)
#else
#define SEAM(k) do { } while (0)
#endif
#define IN(k) (lo <= (k) && (k) < hi)

    if (IN(0)) {
        LAS float* scr = (LAS float*)(lds + wid * 8448);
        const int gw = bx * 8 + wid, NGW = G * 8;
        constexpr int I_UP = (DM / 64) * (NUP / 32), I_DN = (FF / 64) * (DM / 32), I_PL = (512 / 64) * (512 / 32), I_PR = (512 / 64) * (DM / 32);
        constexpr int NITEMS = I_UP + I_DN + I_PL + 2 * I_PR;
        for (int it = gw; it < NITEMS; it += NGW) {
            int r = it;
            if (r < I_UP) { cvt_item<CV_UP>((const float*)a.in[3], (const float*)a.in[4], DM, NUP / 32, W13A, scr, r, lane); continue; } r -= I_UP;
            if (r < I_DN) { cvt_item<CV_NAT>((const float*)a.in[5], nullptr, FF, DM / 32, W2A, scr, r, lane); continue; } r -= I_DN;
            if (r < I_PR) { cvt_item<CV_NAT>((const float*)a.in[13], nullptr, 512, DM / 32, WPA, scr, r, lane); continue; } r -= I_PR;
            if (r < I_PR) { cvt_item<CV_NAT>((const float*)a.in[14], nullptr, 512, DM / 32, WPP, scr, r, lane); continue; } r -= I_PR;
            cvt_item<CV_POOL>((const float*)a.in[10], (const float*)a.in[12], 512, 512 / 32, WPOOL, scr, r, lane);
        }
        const float* g1 = (const float*)a.in[2];
        for (int m = 2 * gw; m < T; m += 2 * NGW) {
            const f32x4* xr = (const f32x4*)(x + (size_t)m * DM) + lane; f32x4 v[2][4]; float s[2] = {0.f, 0.f};
#pragma unroll
            for (int q = 0; q < 2; ++q)
#pragma unroll
                for (int j = 0; j < 4; ++j) v[q][j] = xr[q * (DM / 4) + 64 * j];
#pragma unroll
            for (int q = 0; q < 2; ++q) {
#pragma unroll
                for (int j = 0; j < 4; ++j) s[q] += (v[q][j][0] * v[q][j][0] + v[q][j][1] * v[q][j][1]) + (v[q][j][2] * v[q][j][2] + v[q][j][3] * v[q][j][3]);
                const float rinv = 1.0f / sqrtf(wave_sum(s[q]) * (1.0f / DM) + EPS);
#pragma unroll
                for (int j = 0; j < 4; ++j) { const f32x4 gv = *((const f32x4*)g1 + lane + 64 * j); *((u32x2*)(AB0 + (size_t)(m + q) * DM) + lane + 64 * j) = pack4(v[q][j] * rinv * gv); }
            }
        }
        asm volatile("s_waitcnt vmcnt(0) lgkmcnt(0)" ::: "memory");
        __syncthreads();
    }
    SEAM(0);
    if (IN(1)) { pg8::Gemm g{AB0, W13A, T, NUP, DM}; pg8::StaticOrder S; S.init(T, NUP, G, bx); EpiUp E{Gb, nullptr}; pg8::gemm_phase<EpiUp, pg8::StaticOrder>(lds, g, S, E, nullptr);
        const int nun = (T / 256) * (NUP / 256), rem = nun % G, ntail = rem ? G - rem : G, ti = rem ? bx - rem : bx;
        if (ti >= 0) {
            if (ti < 8) { pg8::Gemm g2{WPP, WPOOL, DM, 512, 512}; pg8::StaticOrder S2; S2.init(DM, 512, 8, ti); EpiPlain E2{WPPF, 512}; pg8::gemm_phase<EpiPlain, pg8::StaticOrder>(lds, g2, S2, E2, nullptr); }
            else {
            if (ti < 40) fold_bias((const float*)a.in[11], (const float*)a.in[12], (const float*)a.in[14], BIASF, (ti - 8) * 512 + tid, 32 * 512);
            if (ntail > 8) {
                const int nw = (ntail - 8) * 8, w0 = (ti - 8) * 8 + wid; LAS float* scr = (LAS float*)(lds + wid * 8448);
                for (int it = w0; it < (DM / 64) * (NIN / 32); it += nw) cvt_item<CV_IN>((const float*)a.in[7], nullptr, DM, NIN / 32, WIN, scr, it, lane, (const float*)a.in[6]);
                for (int i = (ti - 8) * 512 + tid; i < T * 32; i += (ntail - 8) * 512) {
                    const int tok = i >> 5, f = i & 31;
                    const float ang = (float)positions[tok] * INV_FREQ[f];
                    const double rev = (double)ang * 0.15915494309189535; const float fr = (float)(rev - __builtin_rint(rev));
                    CS[i] = __builtin_amdgcn_cosf(fr); SN[i] = __builtin_amdgcn_sinf(fr);
                }
            }
            }
        }
    }
    SEAM(1);
    bf16_t* XB = (bf16_t*)out;
    if (IN(2)) { pg8::Gemm g{Gb, W2A, T, DM, FF}; pg8::StaticOrder S; S.init(T, DM, G, bx); EpiRes<2> E{x, out, ws}; pg8::gemm_phase<EpiRes<2>, pg8::StaticOrder>(lds, g, S, E, nullptr); }
    SEAM(2);
    if (IN(3)) { pg8::Gemm g{XB, WIN, T, NIN, DM}; pg8::StaticOrder S; S.init(T, NIN, G, bx);
        EpiIn E{SS, CS, SN, (const float*)a.in[8], (const float*)a.in[9], Qb, QIb, Kb, KIb, VTb, WIb, Ub, SGA, SGP};
        pg8::gemm_phase<EpiIn, pg8::StaticOrder>(lds, g, S, E, nullptr);
        const int nun = (T / 256) * (NIN / 256), rem = nun % G, ntail = rem ? G - rem : G, ti = rem ? bx - rem : bx;
        if (ti >= 0) {
            constexpr int I_UP = (DM / 64) * (NUP / 32), I_DN = (FF / 64) * (DM / 32), I_OUT = (DM / 64) * (DM / 32);
            const int nw = ntail * 8, w0 = ti * 8 + wid; LAS float* scr = (LAS float*)(lds + wid * 8448);
            for (int it = w0; it < I_UP + I_DN + I_OUT; it += nw) {
                int r = it;
                if (r < I_UP) { cvt_item<CV_UP>((const float*)a.in[17], (const float*)a.in[18], DM, NUP / 32, W13B, scr, r, lane, (const float*)a.in[16]); continue; } r -= I_UP;
                if (r < I_DN) { cvt_item<CV_NAT>((const float*)a.in[19], nullptr, FF, DM / 32, W2B, scr, r, lane); continue; } r -= I_DN;
                cvt_item<CV_NAT>((const float*)a.in[15], nullptr, DM, DM / 32, WOUT, scr, r, lane);
            }
        }
    }
    SEAM(3);
    if (IN(4)) {
        bf16_t* PLD = AB0 + (size_t)T * 512;
        for (int ch = bx; ch < T / 32; ch += G) {
            const int g = tid >> 7, win = 2 << g, t0 = ch * 32, pos0 = t0 % SEQ;
            float h[47];
#pragma unroll
            for (int rr = 0; rr < 47; ++rr) h[rr] = (pos0 + rr - 15 >= 0) ? Ub[(size_t)(t0 + rr - 15) * 512 + tid] : 0.f;
#pragma unroll
            for (int r = 0; r < 32; ++r) {
                const int n = (pos0 + r + 1 < win) ? pos0 + r + 1 : win; float s = 0.f;
#pragma unroll
                for (int j = 0; j < 16; ++j) s += (j < n) ? h[15 + r - j] : 0.f;
                PLD[(size_t)(t0 + r) * 512 + tid] = (bf16_t)(pg8::cvt_pk_bf16(s / (float)n - h[15 + r], 0.f) & 0xffffu);
            }
        }
        float gq = fabsf(((const float*)a.in[8])[lane]), gk = fabsf(((const float*)a.in[9])[lane]);
#pragma unroll
        for (int o_ = 1; o_ < 64; o_ <<= 1) { gq = fmaxf(gq, __shfl_xor(gq, o_)); gk = fmaxf(gk, __shfl_xor(gk, o_)); }
        const P4Ptrs P{Qb, QIb, Kb, KIb, VTb, WIb, AB0, 8.0f * gq * gk * 1.02f * 1.44269504f};
        for (int i = 0; ; ++i) {
            const int sidx = i * G + bx; if (sidx >= T / 16) break;
            const int rnd = sidx / 256, j = sidx % 256, s2 = rnd * 256 + ((rnd & 1) ? 255 - j : j);
            p4_unit(lds, P, s2 & 7, (s2 >> 3) * 16, wid, lane);
        }
    }
    SEAM(4);
    if (IN(6)) {
        { pg8::Gemm g{AB0, WPA, T, DM, 512}; pg8::StaticOrder S; S.init(T, DM, G, bx); EpiProj<0> E{SGA, M1, AB1, nullptr}; pg8::gemm_phase<EpiProj<0>, pg8::StaticOrder>(lds, g, S, E, nullptr); }
        { pg8::Gemm g{AB0 + (size_t)T * 512, WPPF, T, DM, 512}; pg8::StaticOrder S; S.init(T, DM, G, bx); EpiProj<1> E{SGP, M1, AB1, BIASF}; pg8::gemm_phase<EpiProj<1>, pg8::StaticOrder>(lds, g, S, E, nullptr); }
    }
    SEAM(6);
    if (IN(7)) { pg8::Gemm g{AB1, WOUT, T, DM, DM}; pg8::StaticOrder S; S.init(T, DM, G, bx); EpiRes<7> E{x, out, ws}; pg8::gemm_phase<EpiRes<7>, pg8::StaticOrder>(lds, g, S, E, nullptr); }
    SEAM(7);
    if (IN(8)) { pg8::Gemm g{AB0, W13B, T, NUP, DM}; pg8::StaticOrder S; S.init(T, NUP, G, bx); EpiUp E{Gb, SS}; pg8::gemm_phase<EpiUp, pg8::StaticOrder>(lds, g, S, E, nullptr); }
    SEAM(8);
    if (IN(9)) { pg8::Gemm g{Gb, W2B, T, DM, FF}; pg8::StaticOrder S; S.init(T, DM, G, bx); EpiRes<9> E{x, out, ws}; pg8::gemm_phase<EpiRes<9>, pg8::StaticOrder>(lds, g, S, E, nullptr); }
#undef IN
#undef SEAM
}

extern "C" void kernel_launch(void* const* d_in, const int* in_sizes, int n_in, void* d_out, int out_size, void* d_ws, size_t ws_size, hipStream_t stream) {
    static int grid = 0;
    if (grid == 0) {
        if (n_in != 20 || out_size != T * DM || ws_size < WS_END) { fprintf(stderr, "kernel_launch: unexpected shapes (n_in %d out %d ws %zu need %zu)\n", n_in, out_size, ws_size, (size_t)WS_END); grid = -1; return; }
        int dev = 0, cus = 0, per_cu = 0;
        (void)hipGetDevice(&dev); (void)hipDeviceGetAttribute(&cus, hipDeviceAttributeMultiprocessorCount, dev);
        if (hipFuncSetAttribute((const void*)fwd_kernel, hipFuncAttributeMaxDynamicSharedMemorySize, LDS_BYTES) != hipSuccess) { fprintf(stderr, "kernel_launch: hipFuncSetAttribute failed\n"); grid = -1; return; }
        if (hipOccupancyMaxActiveBlocksPerMultiprocessor(&per_cu, (const void*)fwd_kernel, 512, LDS_BYTES) != hipSuccess || per_cu < 1) per_cu = 1;
        (void)hipGetLastError();
        grid = cus * 1;
        fprintf(stderr, "kernel_launch: grid %d (per_cu query %d)\n", grid, per_cu);
    }
    if (grid < 0) return;
    Args a{};
    for (int i = 0; i < 20; ++i) a.in[i] = d_in[i];
    a.out = (float*)d_out; a.ws = (unsigned char*)d_ws;
#if MK_N_LAUNCHES == 1
    a.ph_lo = 0; a.ph_hi = NPHASE;
    void* args[] = {&a};
    if (hipMemsetAsync((char*)d_ws + OFF_BAR, 0, 16384, stream) != hipSuccess) return;
    const hipError_t e = hipLaunchCooperativeKernel((const void*)fwd_kernel, dim3(grid), dim3(512), args, LDS_BYTES, stream);
    if (e != hipSuccess) fprintf(stderr, "kernel_launch: cooperative launch failed: %s\n", hipGetErrorString(e));
#else
    for (int p = 0; p < NPHASE; ++p) { a.ph_lo = p; a.ph_hi = p + 1; hipLaunchKernelGGL(fwd_kernel, dim3(grid), dim3(512), LDS_BYTES, stream, a); }
#endif
}
```

```cpp
#include <hip/hip_runtime.h>
#include <hip/hip_cooperative_groups.h>
#include <cstdio>
namespace cg = cooperative_groups;
namespace pg8 {
#define PG8_LAS __attribute__((address_space(3)))
typedef unsigned short bf16_t;
typedef short bf16x8 __attribute__((ext_vector_type(8)));
typedef float f32x4 __attribute__((ext_vector_type(4)));
typedef unsigned u32x4 __attribute__((ext_vector_type(4)));
constexpr int BM = 256, BK = 64, HALF = 128, HTB = HALF * BK * 2  , STAGE_BYTES = 8 * HTB, NXCD = 8, WGM = 8;

__host__ __device__ __forceinline__ int lds_byte(int r, int c) { const int st = (r >> 4) * 2 + (c >> 5), rr = r & 15, cc = c & 31, ob = rr * 64 + cc * 2; return st * 1024 + (ob ^ (((ob >> 9) & 1) << 5)); }
__host__ __device__ __forceinline__ void stage_rc(int b, int& R, int& C) { const int st = b / 1024, sb = b % 1024, swz = sb ^ (((sb >> 9) & 1) << 5); R = (st >> 1) * 16 + swz / 64; C = (st & 1) * 32 + (swz % 64) / 2; }
__host__ __device__ __forceinline__ int perm32(int rho) { const int n = rho >> 4, i = rho & 15; return 8 * (i >> 2) + 4 * n + (i & 3); }

struct Unit { int pm, pn; };
struct Gemm { const bf16_t* A; const bf16_t* Bt; int M, N, K; };

struct StaticOrder {
    int nM, nN, nwg, G, c;
    __host__ __device__ void init(int M, int N, int G_, int c_) { nM = M / BM; nN = N / BM; nwg = nM * nN; G = G_; c = c_; }
    __host__ __device__ bool next(int i, Unit& u) const {
        const long L = (long)i * G + c; if (L >= nwg) return false;
        int wgid = (int)L; { const int q = nwg / NXCD, r = nwg % NXCD, xcd = wgid % NXCD, off = wgid / NXCD; wgid = (xcd < r ? xcd * (q + 1) : r * (q + 1) + (xcd - r) * q) + off; }
        const int nig = WGM * nN, gid = wgid / nig, fm = gid * WGM, gsz = (nM - fm) < WGM ? (nM - fm) : WGM;
        u.pm = fm + ((wgid % nig) % gsz); u.pn = (wgid % nig) / gsz; return true;
    }
    __device__ __forceinline__ void a_ready(const Unit&) const {}
    __device__ __forceinline__ void done(const Unit&) const {}
};
typedef float cvt_f32x2 __attribute__((ext_vector_type(2)));
typedef __bf16 cvt_bf16x2 __attribute__((ext_vector_type(2)));
__device__ __forceinline__ unsigned cvt_pk_bf16(float lo, float hi) { const cvt_f32x2 v = {lo, hi}; return __builtin_bit_cast(unsigned, __builtin_convertvector(v, cvt_bf16x2)); }
template <class Epi, class Sched, bool STAMP = false>
__device__ __forceinline__ void gemm_phase(PG8_LAS unsigned char* lds, const Gemm g, const Sched& S, const Epi& E, unsigned long long* stamps) {
    const int tid = threadIdx.x, wid = __builtin_amdgcn_readfirstlane(tid >> 6), lane = tid & 63, wr = wid >> 2, wc = wid & 3, fr = lane & 15, fq = lane >> 4;
    const int K = g.K, nt = K / BK;
    int ts_lo = 0, ts_hi = 0, nts = 0; const unsigned long long rt_entry = STAMP ? (unsigned long long)wall_clock64() : 0ull;
#define PG8_STAMP() do { if (STAMP && wid == 0 && nts < 64) { const unsigned long long _c = (unsigned long long)clock64(); \
        ts_lo = (lane == nts) ? (int)(unsigned)_c : ts_lo; ts_hi = (lane == nts) ? (int)(unsigned)(_c >> 32) : ts_hi; ++nts; } } while (0)
    PG8_STAMP();
    unsigned voffA[2], voffB[2];
#pragma unroll
    for (int i = 0; i < 2; ++i) { int R, C; stage_rc(tid * 16 + i * 8192, R, C); const int Rb = Epi::PERM ? ((R & ~31) + perm32(R & 31)) : R;
        voffA[i] = (unsigned)(R * K + C) * 2u; voffB[i] = (unsigned)(Rb * K + C) * 2u; }
    const size_t kstep = (size_t)(BK * 2);
    const size_t hstep = (size_t)HALF * K * 2;
    const size_t tstep = 2 * hstep;
    const unsigned ldsw = (unsigned)wid * 1024u;
    const int aoff = lds_byte(wr * 64 + fr, fq * 8), boff = lds_byte(wc * 32 + fr, fq * 8);
#define PG8_SA(b, h) (((b) * 2 + (h)) * HTB)
#define PG8_SB(b, h) ((4 + (b) * 2 + (h)) * HTB)
#define PG8_STAGE(bufoff, gbase, voff) do { _Pragma("unroll") for (int _i = 0; _i < 2; ++_i) \
        __builtin_amdgcn_global_load_lds((const unsigned*)((const char*)(gbase) + (voff)[_i]), (PG8_LAS unsigned*)(lds + (bufoff) + ldsw + _i * 8192), 16, 0, 0); } while (0)
#define PG8_LDA(dst, b, h) do { _Pragma("unroll") for (int m = 0; m < 4; ++m) _Pragma("unroll") for (int k = 0; k < 2; ++k) dst[m][k] = *(const PG8_LAS bf16x8*)(lds + PG8_SA(b, h) + aoff + m * 2048 + k * 1024); } while (0)
#define PG8_LDB(dst, b, h) do { _Pragma("unroll") for (int n = 0; n < 2; ++n) _Pragma("unroll") for (int k = 0; k < 2; ++k) dst[n][k] = *(const PG8_LAS bf16x8*)(lds + PG8_SB(b, h) + boff + n * 2048 + k * 1024); } while (0)
#define PG8_MMA(ai, bj, At, Bt) do { __builtin_amdgcn_s_setprio(1); _Pragma("unroll") for (int m = 0; m < 4; ++m) _Pragma("unroll") for (int n = 0; n < 2; ++n) _Pragma("unroll") for (int k = 0; k < 2; ++k) \
        acc[ai][bj][m][n] = __builtin_amdgcn_mfma_f32_16x16x32_bf16(Bt[n][k], At[m][k], acc[ai][bj][m][n], 0, 0, 0); __builtin_amdgcn_s_setprio(0); } while (0)
#define PG8_WAIT_V(n) asm volatile("s_waitcnt vmcnt(" #n ")" ::: "memory")
#define PG8_WAIT_L(n) asm volatile("s_waitcnt lgkmcnt(" #n ")" ::: "memory")
#define PG8_BAR __builtin_amdgcn_s_barrier()
#define PG8_SCHED __builtin_amdgcn_sched_barrier(0)
    Unit cur, nxt; int ui = 0;
    if (!S.next(0, cur)) return;
    f32x4 acc[2][2][4][2];
#pragma unroll
    for (int a = 0; a < 2; ++a)
#pragma unroll
        for (int b = 0; b < 2; ++b)
#pragma unroll
            for (int m = 0; m < 4; ++m)
#pragma unroll
                for (int n = 0; n < 2; ++n) acc[a][b][m][n] = (f32x4){0.f, 0.f, 0.f, 0.f};
    bf16x8 At[4][2], B0[2][2], B1[2][2];
    const char* cA = (const char*)g.A + (size_t)cur.pm * tstep; const char* cB = (const char*)g.Bt + (size_t)cur.pn * tstep;
    S.a_ready(cur);
    PG8_STAGE(PG8_SB(0, 0), cB, voffB); PG8_STAGE(PG8_SA(0, 0), cA, voffA); PG8_STAGE(PG8_SB(0, 1), cB + hstep, voffB); PG8_STAGE(PG8_SA(0, 1), cA + hstep, voffA);
    if (wr == 1) PG8_BAR;
    PG8_WAIT_V(4); PG8_BAR;
    PG8_STAGE(PG8_SB(1, 0), cB + kstep, voffB); PG8_STAGE(PG8_SA(1, 0), cA + kstep, voffA); PG8_STAGE(PG8_SB(1, 1), cB + hstep + kstep, voffB);
    PG8_WAIT_V(6); PG8_BAR;
    PG8_STAMP();
    for (;;) {
        const bool has_next = S.next(ui + 1, nxt);
        const char* nA = has_next ? (const char*)g.A + (size_t)nxt.pm * tstep : cA; const char* nB = has_next ? (const char*)g.Bt + (size_t)nxt.pn * tstep : cB;
        for (int t = 0; t < nt; t += 2) {
            const bool last = (t == nt - 2);
            const char* a1 = cA + (size_t)(t + 1) * kstep;
            const char* a2 = last ? nA : cA + (size_t)(t + 2) * kstep; const char* b2 = last ? nB : cB + (size_t)(t + 2) * kstep;
            const char* a3 = a2 + kstep; const char* b3 = b2 + kstep;
            if (last && has_next) S.a_ready(nxt);
            PG8_LDB(B0, 0, 0); PG8_SCHED; PG8_LDA(At, 0, 0); PG8_STAGE(PG8_SA(1, 1), a1 + hstep, voffA);
            PG8_WAIT_L(8); PG8_BAR; PG8_WAIT_L(0); PG8_MMA(0, 0, At, B0); PG8_BAR; PG8_SCHED;
            PG8_LDB(B1, 0, 1); PG8_STAGE(PG8_SB(0, 0), b2, voffB);
            PG8_BAR; PG8_WAIT_L(0); PG8_MMA(0, 1, At, B1); PG8_BAR;
            PG8_LDA(At, 0, 1); PG8_STAGE(PG8_SA(0, 0), a2, voffA);
            PG8_BAR; PG8_WAIT_L(0); PG8_MMA(1, 0, At, B0); PG8_BAR; PG8_SCHED;
            PG8_STAGE(PG8_SB(0, 1), b2 + hstep, voffB);
            PG8_WAIT_V(6); PG8_BAR; PG8_MMA(1, 1, At, B1); PG8_BAR;
            PG8_LDB(B0, 1, 0); PG8_SCHED; PG8_LDA(At, 1, 0); PG8_STAGE(PG8_SA(0, 1), a2 + hstep, voffA);
            PG8_WAIT_L(8); PG8_BAR; PG8_WAIT_L(0); PG8_MMA(0, 0, At, B0); PG8_BAR; PG8_SCHED;
            PG8_LDB(B1, 1, 1); PG8_STAGE(PG8_SB(1, 0), b3, voffB);
            PG8_BAR; PG8_WAIT_L(0); PG8_MMA(0, 1, At, B1); PG8_BAR;
            PG8_LDA(At, 1, 1); PG8_STAGE(PG8_SA(1, 0), a3, voffA);
            PG8_BAR; PG8_WAIT_L(0); PG8_MMA(1, 0, At, B0); PG8_BAR; PG8_SCHED;
            PG8_STAGE(PG8_SB(1, 1), b3 + hstep, voffB);
            PG8_WAIT_V(6); PG8_BAR; PG8_MMA(1, 1, At, B1); PG8_BAR;
        }
        PG8_STAMP();
        if constexpr (!Epi::AFTER_DRAIN) { E(acc, cur, wr, wc, fr, fq); S.done(cur); }
        PG8_STAMP();
        if (!has_next) break;
#pragma unroll
        for (int a = 0; a < 2; ++a)
#pragma unroll
            for (int b = 0; b < 2; ++b)
#pragma unroll
                for (int m = 0; m < 4; ++m)
#pragma unroll
                    for (int n = 0; n < 2; ++n) acc[a][b][m][n] = (f32x4){0.f, 0.f, 0.f, 0.f};
        cur = nxt; cA = nA; cB = nB; ++ui;
    }
    PG8_WAIT_V(0);
    if (wr == 0) PG8_BAR;
    PG8_BAR;
    if constexpr (Epi::AFTER_DRAIN) { E.fused(acc, cur, wr, wc, fr, fq, lds, wid, lane); S.done(cur); }
    PG8_STAMP();
    if (STAMP && wid == 0) { stamps[lane] = lane < nts ? (((unsigned long long)(unsigned)ts_hi << 32) | (unsigned)ts_lo) : 0ull;
        if (lane == 62) stamps[62] = rt_entry; if (lane == 63) stamps[63] = (unsigned long long)wall_clock64(); }
#undef PG8_STAMP
#undef PG8_SA
#undef PG8_SB
#undef PG8_STAGE
#undef PG8_LDA
#undef PG8_LDB
#undef PG8_MMA
#undef PG8_WAIT_V
#undef PG8_WAIT_L
#undef PG8_BAR
#undef PG8_SCHED
}
}

#define LAS __attribute__((address_space(3)))
typedef unsigned short bf16_t;
typedef pg8::bf16x8 bf16x8;
typedef pg8::f32x4 f32x4;
typedef unsigned u32x2 __attribute__((ext_vector_type(2)));
typedef unsigned u32x4 __attribute__((ext_vector_type(4)));

constexpr int NB = 8, SEQ = 2048, DM = 1024, T = NB * SEQ, FF = 2816, NUP = 2 * FF, NIN = 3840, DIN = 3784;
constexpr float EPS = 1e-6f;
constexpr int LDS_BYTES = 155648;
constexpr int SCS = 2064;
constexpr int KT_OFF = 16 * SCS * 4;
constexpr int VT_OFF = KT_OFF + 64 * 144;
static_assert(VT_OFF + 64 * 144 <= LDS_BYTES, "LDS map");

constexpr size_t OFF_W13A = 0;
constexpr size_t OFF_W2A  = OFF_W13A + (size_t)NUP * DM * 2;
constexpr size_t OFF_WIN  = OFF_W2A + (size_t)DM * FF * 2;
constexpr size_t OFF_WPOOL = OFF_WIN + (size_t)NIN * DM * 2;
constexpr size_t OFF_WPA  = OFF_WPOOL + (size_t)512 * 512 * 2;
constexpr size_t OFF_WPP  = OFF_WPA + (size_t)DM * 512 * 2;
constexpr size_t OFF_WOUT = OFF_WPP + (size_t)DM * 512 * 2;
constexpr size_t OFF_W13B = OFF_WOUT + (size_t)DM * DM * 2;
constexpr size_t OFF_W2B  = OFF_W13B + (size_t)NUP * DM * 2;
constexpr size_t OFF_ROPE = OFF_W2B + (size_t)DM * FF * 2;
constexpr size_t OFF_SS   = OFF_ROPE + (size_t)T * 32 * 4 * 2;
constexpr size_t OFF_AB0  = OFF_SS + (size_t)T * 16 * 4;
constexpr size_t OFF_AB1  = OFF_AB0 + (size_t)T * DM * 2;
constexpr size_t OFF_R    = OFF_AB1 + (size_t)T * DM * 2;
constexpr size_t OFF_SGA  = OFF_R;
constexpr size_t OFF_SGP  = OFF_SGA + (size_t)T * DM * 2;
constexpr size_t OFF_Q    = OFF_SGP + (size_t)T * DM * 2;
constexpr size_t OFF_QI   = OFF_Q + (size_t)T * 512 * 2;
constexpr size_t OFF_U    = OFF_QI + (size_t)T * 512 * 2;
constexpr size_t OFF_K    = OFF_U + (size_t)T * 512 * 4;
constexpr size_t OFF_KI   = OFF_K + (size_t)T * 64 * 2;
constexpr size_t OFF_VT   = OFF_KI + (size_t)T * 64 * 2;
constexpr size_t OFF_WI   = OFF_VT + (size_t)T * 64 * 2;
constexpr size_t OFF_BAR  = OFF_WI + (size_t)T * 8 * 4;
constexpr size_t OFF_BIASF = OFF_BAR + 16384;
constexpr size_t OFF_WPPF = OFF_BIASF + 4096;
constexpr size_t WS_END   = OFF_WPPF + (size_t)DM * 512 * 2;
constexpr size_t OFF_G    = OFF_R;
constexpr size_t OFF_M1   = OFF_Q;
static_assert(OFF_G + (size_t)T * FF * 2 <= WS_END && OFF_M1 + (size_t)T * DM * 4 <= OFF_K, "overlay map");

__constant__ float INV_FREQ[32] = {1.000000000e+00f, 7.498942614e-01f, 5.623413324e-01f, 4.216965139e-01f, 3.162277639e-01f, 2.371373773e-01f, 1.778279394e-01f, 1.333521307e-01f, 1.000000015e-01f, 7.498941571e-02f, 5.623413250e-02f, 4.216965288e-02f, 3.162277490e-02f, 2.371373773e-02f, 1.778279431e-02f, 1.333521493e-02f, 9.999999776e-03f, 7.498941850e-03f, 5.623413250e-03f, 4.216964822e-03f, 3.162277630e-03f, 2.371373586e-03f, 1.778279431e-03f, 1.333521446e-03f, 1.000000047e-03f, 7.498942432e-04f, 5.623413017e-04f, 4.216965172e-04f, 3.162277571e-04f, 2.371373703e-04f, 1.778279402e-04f, 1.333521504e-04f};

__device__ __forceinline__ float bf_lo(unsigned w) { return __uint_as_float(w << 16); }
__device__ __forceinline__ float bf_hi(unsigned w) { return __uint_as_float(w & 0xffff0000u); }
__device__ __forceinline__ u32x2 pack4(f32x4 v) { u32x2 w; w.x = pg8::cvt_pk_bf16(v[0], v[1]); w.y = pg8::cvt_pk_bf16(v[2], v[3]); return w; }
__device__ __forceinline__ float sum4(f32x4 v) { return (v[0] + v[1]) + (v[2] + v[3]); }
__device__ __forceinline__ float sigmoidf_(float x) { return __builtin_amdgcn_rcpf(1.0f + __builtin_amdgcn_exp2f(-1.44269504f * x)); }
__device__ __forceinline__ float wave_sum(float v) {
#pragma unroll
    for (int o = 1; o < 64; o <<= 1) v += __shfl_xor(v, o);
    return v;
}
__device__ __forceinline__ void row_rinv8(const float* ss, int row0, int fq, float (&rs)[2][4]) {
    f32x4 part[2][4];
#pragma unroll
    for (int ai = 0; ai < 2; ++ai)
#pragma unroll
        for (int m = 0; m < 4; ++m) part[ai][m] = *(const f32x4*)(ss + (size_t)(row0 + ai * 128 + m * 16) * 16 + 4 * fq);
#pragma unroll
    for (int ai = 0; ai < 2; ++ai)
#pragma unroll
        for (int m = 0; m < 4; ++m) { float s = sum4(part[ai][m]); s += __shfl_xor(s, 16); s += __shfl_xor(s, 32); rs[ai][m] = __builtin_amdgcn_rsqf(s * (1.0f / DM) + EPS); }
}

enum { CV_NAT = 0, CV_UP = 1, CV_IN = 2, CV_POOL = 3 };
template <int MODE>
__device__ __forceinline__ void cvt_item(const float* s0, const float* s1, int K, int nblk, bf16_t* WT, LAS float* scr, int item, int lane, const float* gk = nullptr) {
    const int kb = item / nblk, nb = item % nblk, k0 = 64 * kb, R = 32 * nb + (lane & 31);
    const float* p = s0; int ld = nblk * 32, col = R, ks0 = k0; bool valid = true;
    if (MODE == CV_UP) { const int pn = R >> 8, bj = (R >> 7) & 1, wc = (R >> 5) & 3, n = (R >> 4) & 1, fq = (R >> 2) & 3, e = R & 3; p = n ? s1 : s0; ld = FF; col = 128 * pn + 32 * wc + 8 * fq + 4 * bj + e; }
    if (MODE == CV_IN) {
        const int pn = R >> 8, rem = R & 255, bj = rem >> 7, wc = (rem >> 5) & 3; ld = DIN;
        const bool hperm = pn < 5 && !(pn == 2 && wc >= 2);
        const int j = hperm ? pg8::perm32(rem & 31) : (rem & 31);
        if (pn < 2) col = 64 * (4 * pn + wc) + 32 * bj + j;
        else if (pn == 2) {
            if (wc == 0) col = 512 + 32 * bj + j; else if (wc == 1) col = 1152 + 32 * bj + j; else if (wc == 2) col = 576 + 32 * bj + j;
            else { col = 1216 + (j & 7); valid = (bj == 0 && j < 8); }
        }
        else if (pn < 5) col = 640 + 64 * (4 * (pn - 3) + wc) + 32 * bj + j;
        else if (pn < 7) col = 1224 + 256 * (pn - 5) + rem;
        else if (pn < 11) col = 1736 + 256 * (pn - 7) + rem;
        else col = 2760 + 256 * (pn - 11) + rem;
    }
    if (MODE == CV_POOL) { const int g = R >> 7; p = s0 + g * 16384 + (R & 127) * 128; ld = 1; col = 0; valid = ((k0 >> 7) == g); ks0 = k0 & 127; }
    float tv[32];
#pragma unroll
    for (int i = 0; i < 32; ++i) { const int kk = 2 * i + (lane >> 5); tv[i] = valid ? p[(size_t)(ks0 + kk) * ld + col] : 0.f; }
#pragma unroll
    for (int i = 0; i < 32; ++i) { const int kk = 2 * i + (lane >> 5); float v_ = tv[i]; if (MODE == CV_POOL) v_ *= s1[k0 + kk]; if (gk) v_ *= gk[k0 + kk]; scr[kk * 33 + (lane & 31)] = v_; }
    asm volatile("s_waitcnt lgkmcnt(0)" ::: "memory");
    const int c = lane & 7;
#pragma unroll
    for (int j = 0; j < 4; ++j) { const int n = (lane >> 3) + 8 * j; const LAS float* s = scr + (8 * c) * 33 + n;
        u32x4 o; o.x = pg8::cvt_pk_bf16(s[0 * 33], s[1 * 33]); o.y = pg8::cvt_pk_bf16(s[2 * 33], s[3 * 33]); o.z = pg8::cvt_pk_bf16(s[4 * 33], s[5 * 33]); o.w = pg8::cvt_pk_bf16(s[6 * 33], s[7 * 33]);
        *(u32x4*)(WT + (size_t)(32 * nb + n) * K + k0 + 8 * c) = o; }
    asm volatile("s_waitcnt lgkmcnt(0)" ::: "memory");
}

typedef float f32x2 __attribute__((ext_vector_type(2)));
__device__ __forceinline__ f32x2 swiglu_pk(f32x2 a, f32x2 b) {
    const f32x2 t = a * (-1.44269504f); f32x2 e; e.x = __builtin_amdgcn_exp2f(t.x); e.y = __builtin_amdgcn_exp2f(t.y);
    const f32x2 d = e + 1.0f; f32x2 r; r.x = __builtin_amdgcn_rcpf(d.x); r.y = __builtin_amdgcn_rcpf(d.y);
    return (a * r) * b;
}
struct EpiUp {
    static constexpr bool PERM = false, AFTER_DRAIN = false;
    bf16_t* G; const float* ss;
    __device__ __forceinline__ void operator()(const f32x4 (&acc)[2][2][4][2], const pg8::Unit& u, int wr, int wc, int fr, int fq) const {
        float rs8[2][4];
        if (ss) row_rinv8(ss, u.pm * 256 + wr * 64 + fr, fq, rs8);
#pragma unroll
        for (int ai = 0; ai < 2; ++ai)
#pragma unroll
            for (int m = 0; m < 4; ++m) {
                const int r = u.pm * 256 + ai * 128 + wr * 64 + m * 16 + fr;
                const float rs = ss ? rs8[ai][m] : 1.0f;
                u32x4 w;
#pragma unroll
                for (int bj = 0; bj < 2; ++bj) {
                    const f32x4 a = acc[ai][bj][m][0], b = acc[ai][bj][m][1];
                    f32x2 a0 = {a[0], a[1]}, a1 = {a[2], a[3]}, b0 = {b[0], b[1]}, b1 = {b[2], b[3]};
                    if (ss) { a0 = a0 * rs; a1 = a1 * rs; b0 = b0 * rs; b1 = b1 * rs; }
                    const f32x2 g0 = swiglu_pk(a0, b0), g1 = swiglu_pk(a1, b1);
                    if (bj == 0) { w.x = pg8::cvt_pk_bf16(g0.x, g0.y); w.y = pg8::cvt_pk_bf16(g1.x, g1.y); } else { w.z = pg8::cvt_pk_bf16(g0.x, g0.y); w.w = pg8::cvt_pk_bf16(g1.x, g1.y); }
                }
                *(u32x4*)(G + (size_t)r * FF + u.pn * 128 + wc * 32 + 8 * fq) = w;
            }
    }
};
template <int PH> struct EpiRes {
    static constexpr bool PERM = true, AFTER_DRAIN = false;
    const float* x; float* out; unsigned char* ws;
    __device__ __forceinline__ void operator()(const f32x4 (&acc)[2][2][4][2], const pg8::Unit& u, int wr, int wc, int fr, int fq) const {
        constexpr bool RES_BF16 = PH != 2, OUT_F32 = PH == 9; constexpr float alpha = PH == 7 ? 1.0f : 0.5f;
        const float* resf = x; const bf16_t* resb = PH == 7 ? (const bf16_t*)out : (const bf16_t*)(ws + OFF_AB0);
        bf16_t* xb = PH == 2 ? (bf16_t*)out : (bf16_t*)(ws + OFF_AB0); float* ss = (float*)(ws + OFF_SS);
#pragma unroll
        for (int ai = 0; ai < 2; ++ai) {
            f32x4 r0[4][2], r1[4][2];
#pragma unroll
            for (int m = 0; m < 4; ++m)
#pragma unroll
                for (int bj = 0; bj < 2; ++bj) {
                    const size_t off = (size_t)(u.pm * 256 + ai * 128 + wr * 64 + m * 16 + fr) * DM + u.pn * 256 + bj * 128 + wc * 32 + 8 * fq;
                    if (RES_BF16) { const u32x4 w = *(const u32x4*)(resb + off); r0[m][bj] = (f32x4){bf_lo(w.x), bf_hi(w.x), bf_lo(w.y), bf_hi(w.y)}; r1[m][bj] = (f32x4){bf_lo(w.z), bf_hi(w.z), bf_lo(w.w), bf_hi(w.w)}; }
                    else { r0[m][bj] = *(const f32x4*)(resf + off); r1[m][bj] = *(const f32x4*)(resf + off + 4); }
                }
#pragma unroll
            for (int m = 0; m < 4; ++m) {
                const int r = u.pm * 256 + ai * 128 + wr * 64 + m * 16 + fr; float sq = 0.f;
#pragma unroll
                for (int bj = 0; bj < 2; ++bj) {
                    const size_t off = (size_t)r * DM + u.pn * 256 + bj * 128 + wc * 32 + 8 * fq;
                    const f32x4 o0 = r0[m][bj] + acc[ai][bj][m][0] * alpha, o1 = r1[m][bj] + acc[ai][bj][m][1] * alpha;
                    if (OUT_F32) { *(f32x4*)(out + off) = o0; *(f32x4*)(out + off + 4) = o1; }
                    else { sq += ((o0[0] * o0[0] + o0[1] * o0[1]) + (o0[2] * o0[2] + o0[3] * o0[3])) + ((o1[0] * o1[0] + o1[1] * o1[1]) + (o1[2] * o1[2] + o1[3] * o1[3]));
                           const u32x2 p0 = pack4(o0), p1 = pack4(o1); u32x4 w; w.x = p0.x; w.y = p0.y; w.z = p1.x; w.w = p1.y; *(u32x4*)(xb + off) = w; }
                }
                if (!OUT_F32) { sq += __shfl_xor(sq, 16); sq += __shfl_xor(sq, 32); if (fq == 0) ss[(size_t)r * 16 + u.pn * 4 + wc] = sq; }
            }
        }
    }
};
struct EpiIn {
    static constexpr bool PERM = false, AFTER_DRAIN = false;
    const float* ss; const float* cs; const float* sn; const float* qn; const float* kn;
    bf16_t *Q, *QI, *K, *KI, *VT; float *WI, *U; bf16_t *SGA, *SGP;
    __device__ __forceinline__ void operator()(const f32x4 (&acc)[2][2][4][2], const pg8::Unit& u, int wr, int wc, int fr, int fq) const {
        const int pn = u.pn;
        float rs8[2][4];
        row_rinv8(ss, u.pm * 256 + wr * 64 + fr, fq, rs8);
        const bool norm_unit = pn < 2 || (pn == 2 && wc == 0);
        f32x4 gain[2][2];
#pragma unroll
        for (int bj = 0; bj < 2; ++bj)
#pragma unroll
            for (int n = 0; n < 2; ++n) gain[bj][n] = norm_unit ? *(const f32x4*)((pn < 2 ? qn : kn) + 32 * bj + 8 * fq + 4 * n) : (f32x4){1.f, 1.f, 1.f, 1.f};
#pragma unroll
        for (int ai = 0; ai < 2; ++ai)
#pragma unroll
            for (int m = 0; m < 4; ++m) {
                const int r = u.pm * 256 + ai * 128 + wr * 64 + m * 16 + fr;
                const float rs = rs8[ai][m];
                f32x4 v[2][2];
#pragma unroll
                for (int bj = 0; bj < 2; ++bj)
#pragma unroll
                    for (int n = 0; n < 2; ++n) v[bj][n] = acc[ai][bj][m][n] * rs;
                if (pn < 5) {
                    const bool is_q = pn < 2, is_misc = pn == 2;
                    const bool do_norm = is_q || (is_misc && wc == 0), do_rope = !(is_misc && wc >= 2);
                    if (do_norm) {
                        float sq = 0.f;
#pragma unroll
                        for (int bj = 0; bj < 2; ++bj)
#pragma unroll
                            for (int n = 0; n < 2; ++n) sq += (v[bj][n][0] * v[bj][n][0] + v[bj][n][1] * v[bj][n][1]) + (v[bj][n][2] * v[bj][n][2] + v[bj][n][3] * v[bj][n][3]);
                        sq += __shfl_xor(sq, 16); sq += __shfl_xor(sq, 32);
                        const float rn = __builtin_amdgcn_rsqf(sq * (1.0f / 64.0f) + EPS);
#pragma unroll
                        for (int bj = 0; bj < 2; ++bj)
#pragma unroll
                            for (int n = 0; n < 2; ++n) v[bj][n] = v[bj][n] * rn * gain[bj][n];
                    }
                    if (do_rope) {
#pragma unroll
                        for (int n = 0; n < 2; ++n) {
                            const f32x4 c4 = *(const f32x4*)(cs + (size_t)r * 32 + 8 * fq + 4 * n), s4 = *(const f32x4*)(sn + (size_t)r * 32 + 8 * fq + 4 * n);
                            const f32x4 x1 = v[0][n], x2 = v[1][n];
                            v[0][n] = x1 * c4 - x2 * s4; v[1][n] = x2 * c4 + x1 * s4;
                        }
                    }
                    if (is_misc && wc == 2) {
                        const int b = r / SEQ, s = r % SEQ;
#pragma unroll
                        for (int bj = 0; bj < 2; ++bj)
#pragma unroll
                            for (int n = 0; n < 2; ++n)
#pragma unroll
                                for (int e = 0; e < 4; ++e) { const int d = 32 * bj + 16 * n + 4 * fq + e; VT[((size_t)b * 64 + d) * SEQ + s] = (bf16_t)(pg8::cvt_pk_bf16(v[bj][n][e], 0.f) & 0xffffu); }
                    } else if (is_misc && wc == 3) {
                        if (fq < 2) *(f32x4*)(WI + (size_t)r * 8 + 4 * fq) = v[0][0];
                    } else {
                        bf16_t* dst;
                        if (is_q) dst = Q + ((size_t)r * 8 + 4 * pn + wc) * 64;
                        else if (is_misc) dst = (wc == 0 ? K : KI) + (size_t)r * 64;
                        else dst = QI + ((size_t)r * 8 + 4 * (pn - 3) + wc) * 64;
#pragma unroll
                        for (int bj = 0; bj < 2; ++bj) { const u32x2 p0 = pack4(v[bj][0]), p1 = pack4(v[bj][1]); u32x4 w; w.x = p0.x; w.y = p0.y; w.z = p1.x; w.w = p1.y; *(u32x4*)(dst + 32 * bj + 8 * fq) = w; }
                    }
                } else if (pn < 7) {
#pragma unroll
                    for (int bj = 0; bj < 2; ++bj)
#pragma unroll
                        for (int n = 0; n < 2; ++n) *(f32x4*)(U + (size_t)r * 512 + 256 * (pn - 5) + 128 * bj + 32 * wc + 16 * n + 4 * fq) = v[bj][n];
                } else {
                    bf16_t* dst = (pn < 11) ? SGA + (size_t)r * DM + 256 * (pn - 7) : SGP + (size_t)r * DM + 256 * (pn - 11);
#pragma unroll
                    for (int bj = 0; bj < 2; ++bj)
#pragma unroll
                        for (int n = 0; n < 2; ++n) { f32x4 g;
#pragma unroll
                            for (int e = 0; e < 4; ++e) g[e] = sigmoidf_(v[bj][n][e]);
                            *(u32x2*)(dst + 128 * bj + 32 * wc + 16 * n + 4 * fq) = pack4(g); }
                }
            }
    }
};
struct EpiPlain {
    static constexpr bool PERM = false, AFTER_DRAIN = false;
    bf16_t* O; int ldo;
    __device__ __forceinline__ void operator()(const f32x4 (&acc)[2][2][4][2], const pg8::Unit& u, int wr, int wc, int fr, int fq) const {
#pragma unroll
        for (int ai = 0; ai < 2; ++ai)
#pragma unroll
            for (int m = 0; m < 4; ++m)
#pragma unroll
                for (int bj = 0; bj < 2; ++bj)
#pragma unroll
                    for (int n = 0; n < 2; ++n)
                        *(u32x2*)(O + (size_t)(u.pm * 256 + ai * 128 + wr * 64 + m * 16 + fr) * ldo + u.pn * 256 + bj * 128 + wc * 32 + n * 16 + 4 * fq) = pack4(acc[ai][bj][m][n]);
    }
};
template <int STEP> struct EpiProj {
    static constexpr bool PERM = true, AFTER_DRAIN = false;
    const bf16_t* SG; bf16_t* M1; bf16_t* MG; const float* bias;
    __device__ __forceinline__ void operator()(const f32x4 (&acc)[2][2][4][2], const pg8::Unit& u, int wr, int wc, int fr, int fq) const {
        f32x4 b0[2], b1[2];
#pragma unroll
        for (int bj = 0; bj < 2; ++bj) { const int c = u.pn * 256 + bj * 128 + wc * 32 + 8 * fq; b0[bj] = (f32x4){0.f, 0.f, 0.f, 0.f}; b1[bj] = b0[bj]; if (STEP == 1) { b0[bj] = *(const f32x4*)(bias + c); b1[bj] = *(const f32x4*)(bias + c + 4); } }
#pragma unroll
        for (int ai = 0; ai < 2; ++ai) {
            u32x4 gw[4][2], mw[4][2];
#pragma unroll
            for (int m = 0; m < 4; ++m)
#pragma unroll
                for (int bj = 0; bj < 2; ++bj) {
                    const size_t off = (size_t)(u.pm * 256 + ai * 128 + wr * 64 + m * 16 + fr) * DM + u.pn * 256 + bj * 128 + wc * 32 + 8 * fq;
                    gw[m][bj] = *(const u32x4*)(SG + off); if (STEP == 1) mw[m][bj] = *(const u32x4*)(M1 + off);
                }
#pragma unroll
            for (int m = 0; m < 4; ++m)
#pragma unroll
                for (int bj = 0; bj < 2; ++bj) {
                    const size_t off = (size_t)(u.pm * 256 + ai * 128 + wr * 64 + m * 16 + fr) * DM + u.pn * 256 + bj * 128 + wc * 32 + 8 * fq;
                    const u32x4 g = gw[m][bj];
                    const f32x4 g0 = {bf_lo(g.x), bf_hi(g.x), bf_lo(g.y), bf_hi(g.y)}, g1 = {bf_lo(g.z), bf_hi(g.z), bf_lo(g.w), bf_hi(g.w)};
                    f32x4 o0, o1;
                    if (STEP == 0) { o0 = g0 * acc[ai][bj][m][0]; o1 = g1 * acc[ai][bj][m][1]; }
                    else { const u32x4 mm = mw[m][bj];
                           o0 = (f32x4){bf_lo(mm.x), bf_hi(mm.x), bf_lo(mm.y), bf_hi(mm.y)} + g0 * (acc[ai][bj][m][0] + b0[bj]);
                           o1 = (f32x4){bf_lo(mm.z), bf_hi(mm.z), bf_lo(mm.w), bf_hi(mm.w)} + g1 * (acc[ai][bj][m][1] + b1[bj]); }
                    const u32x2 p0 = pack4(o0), p1 = pack4(o1); u32x4 w; w.x = p0.x; w.y = p0.y; w.z = p1.x; w.w = p1.y;
                    *(u32x4*)((STEP == 0 ? M1 : MG) + off) = w;
                }
        }
    }
};

__device__ __forceinline__ int count_gt8(int c, unsigned mid, unsigned k0, unsigned k1, unsigned k2, unsigned k3, unsigned k4, unsigned k5, unsigned k6, unsigned k7) {
    unsigned long long m0, m1, m2, m3, m4, m5, m6, m7; int t0, t1;
    asm volatile("v_cmp_lt_u32_e64 %[m0], %[mid], %[k0]\n\tv_cmp_lt_u32_e64 %[m1], %[mid], %[k1]\n\tv_cmp_lt_u32_e64 %[m2], %[mid], %[k2]\n\tv_cmp_lt_u32_e64 %[m3], %[mid], %[k3]\n\t"
                 "v_cmp_lt_u32_e64 %[m4], %[mid], %[k4]\n\tv_cmp_lt_u32_e64 %[m5], %[mid], %[k5]\n\tv_cmp_lt_u32_e64 %[m6], %[mid], %[k6]\n\tv_cmp_lt_u32_e64 %[m7], %[mid], %[k7]\n\t"
                 "s_bcnt1_i32_b64 %[t0], %[m0]\n\ts_bcnt1_i32_b64 %[t1], %[m1]\n\ts_add_i32 %[c], %[c], %[t0]\n\ts_bcnt1_i32_b64 %[t0], %[m2]\n\ts_add_i32 %[c], %[c], %[t1]\n\ts_bcnt1_i32_b64 %[t1], %[m3]\n\t"
                 "s_add_i32 %[c], %[c], %[t0]\n\ts_bcnt1_i32_b64 %[t0], %[m4]\n\ts_add_i32 %[c], %[c], %[t1]\n\ts_bcnt1_i32_b64 %[t1], %[m5]\n\ts_add_i32 %[c], %[c], %[t0]\n\ts_bcnt1_i32_b64 %[t0], %[m6]\n\t"
                 "s_add_i32 %[c], %[c], %[t1]\n\ts_bcnt1_i32_b64 %[t1], %[m7]\n\ts_add_i32 %[c], %[c], %[t0]\n\ts_add_i32 %[c], %[c], %[t1]"
                 : [c] "+s"(c), [m0] "=&s"(m0), [m1] "=&s"(m1), [m2] "=&s"(m2), [m3] "=&s"(m3), [m4] "=&s"(m4), [m5] "=&s"(m5), [m6] "=&s"(m6), [m7] "=&s"(m7), [t0] "=&s"(t0), [t1] "=&s"(t1)
                 : [mid] "s"(mid), [k0] "v"(k0), [k1] "v"(k1), [k2] "v"(k2), [k3] "v"(k3), [k4] "v"(k4), [k5] "v"(k5), [k6] "v"(k6), [k7] "v"(k7)
                 : "scc");
    return c;
}
__device__ __forceinline__ unsigned ord_key(float v) { const unsigned b = __float_as_uint(v); return (b & 0x80000000u) ? ~b : (b | 0x80000000u); }

__device__ __forceinline__ void select_row(LAS float* srow, int t, int nreg, int lane, unsigned kept) {
    LAS unsigned* mrow = (LAS unsigned*)srow;
    const int ngrp = (nreg + 7) >> 3;
    unsigned ku[32];
#pragma unroll
    for (int g = 0; g < 4; ++g) {
        if (g < ngrp) {
#pragma unroll
            for (int j = 0; j < 8; ++j) { const int i = 8 * g + j, key = 64 * i + lane; const float sv = srow[key]; ku[i] = ord_key((key <= t) ? sv : -__builtin_inff()); }
        } else {
#pragma unroll
            for (int j = 0; j < 8; ++j) ku[8 * g + j] = 0x007fffffu;
        }
    }
    if (t + 1 <= 256) {
#pragma unroll
        for (int g = 0; g < 4; ++g) if (g < ngrp) {
#pragma unroll
            for (int j = 0; j < 8; ++j) { const int key = 64 * (8 * g + j) + lane; mrow[key] = (key <= t) ? kept : 0xff800000u; }
        }
        return;
    }
    unsigned lo = 0u, hi = 0xffffffffu; int chi = 0; bool exact = false;
    while (hi - lo > 1u) {
        const unsigned mid = lo + ((hi - lo) >> 1); int c = 0;
#pragma unroll
        for (int g = 0; g < 4; ++g) if (g < ngrp) {
            c = count_gt8(c, mid, ku[8 * g], ku[8 * g + 1], ku[8 * g + 2], ku[8 * g + 3], ku[8 * g + 4], ku[8 * g + 5], ku[8 * g + 6], ku[8 * g + 7]);
        }
        if (c == 256) { hi = mid; chi = c; exact = true; break; }
        if (c > 256) lo = mid; else { hi = mid; chi = c; }
    }
    int need = exact ? 0 : (256 - chi);
#pragma unroll
    for (int g = 0; g < 4; ++g) if (g < ngrp) {
#pragma unroll
        for (int j = 0; j < 8; ++j) {
            const int i = 8 * g + j; bool keep = ku[i] > hi;
            if (need > 0) {
                unsigned long long eq = __ballot(ku[i] == hi); int cnt = __popcll(eq);
                while (cnt > need) { eq &= ~(1ull << (63 - __builtin_clzll(eq))); --cnt; }
                need -= cnt; keep = keep || ((eq >> lane) & 1ull);
            }
            mrow[64 * i + lane] = keep ? kept : 0xff800000u;
        }
    }
}

struct P4Ptrs { const bf16_t *Q, *QI, *K, *KI, *VT; const float* WI; bf16_t* Y; float bc; };

__device__ __forceinline__ void p4_unit(LAS unsigned char* lds, const P4Ptrs& P, int b, int q0, int wid, int lane) {
    LAS float* sc = (LAS float*)lds;
    const int lg = lane >> 4, ln = lane & 15; const size_t tb = (size_t)b * SEQ;
    const int nstep = (q0 + 16 + 31) / 32;
    {
        bf16x8 aX[4][2], aY[4][2]; float w[4][8];
        const float idx_scale = 0.125f * 0.35355339059327373f;
#pragma unroll
        for (int g = 0; g < 4; ++g) {
            const bf16_t* pq = P.QI + ((tb + q0 + 4 * g + (ln >> 2)) * 8 + (ln & 3)) * 64 + 8 * lg;
#pragma unroll
            for (int ks = 0; ks < 2; ++ks) { aX[g][ks] = *(const bf16x8*)(pq + 32 * ks); aY[g][ks] = *(const bf16x8*)(pq + 256 + 32 * ks); }
            const f32x4* pw = (const f32x4*)(P.WI + (tb + q0 + 4 * g + lg) * 8); const f32x4 w0 = pw[0], w1 = pw[1];
#pragma unroll
            for (int e = 0; e < 4; ++e) { w[g][e] = w0[e] * idx_scale; w[g][4 + e] = w1[e] * idx_scale; }
        }
        const int ntile = q0 / 16 + 1;
        const bf16_t* pk = P.KI + (tb + 16 * wid + ln) * 64 + 8 * lg;
        bf16x8 b0n = {0, 0, 0, 0, 0, 0, 0, 0}, b1n = b0n;
        if (wid < ntile) { b0n = *(const bf16x8*)pk; b1n = *(const bf16x8*)(pk + 32); }
        for (int kt = wid; kt < ntile; kt += 8) {
            const bf16x8 b0 = b0n, b1 = b1n;
            pk += 8 * 16 * 64;
            if (kt + 8 < ntile) { b0n = *(const bf16x8*)pk; b1n = *(const bf16x8*)(pk + 32); }
#pragma unroll
            for (int g = 0; g < 4; ++g) {
                f32x4 x = {0.f, 0.f, 0.f, 0.f}, y = {0.f, 0.f, 0.f, 0.f};
                x = __builtin_amdgcn_mfma_f32_16x16x32_bf16(aX[g][0], b0, x, 0, 0, 0); x = __builtin_amdgcn_mfma_f32_16x16x32_bf16(aX[g][1], b1, x, 0, 0, 0);
                y = __builtin_amdgcn_mfma_f32_16x16x32_bf16(aY[g][0], b0, y, 0, 0, 0); y = __builtin_amdgcn_mfma_f32_16x16x32_bf16(aY[g][1], b1, y, 0, 0, 0);
                float s = 0.f;
#pragma unroll
                for (int e = 0; e < 4; ++e) { s += w[g][e] * fmaxf(x[e], 0.f); s += w[g][4 + e] * fmaxf(y[e], 0.f); }
                sc[(4 * g + lg) * SCS + 16 * kt + ln] = s;
            }
        }
    }
    __syncthreads();
    constexpr int HPW = 2, NHG = 8 / HPW, NKS = 8 / NHG, CBW = HPW * 16 + HPW; const int hg = wid / NKS, ksp = wid % NKS;
    bf16x8 qb[HPW][2];
#pragma unroll
    for (int h = 0; h < HPW; ++h) { const bf16_t* pq = P.Q + ((tb + q0 + ln) * 8 + HPW * hg + h) * 64 + 8 * lg; qb[h][0] = *(const bf16x8*)pq; qb[h][1] = *(const bf16x8*)(pq + 32); }
    const int tid = wid * 64 + lane, srow_ = tid >> 3, sch = tid & 7;
    const bf16_t* gk = P.K + (tb + srow_) * 64 + 8 * sch;
    const bf16_t* gv = P.VT + ((size_t)b * 64 + srow_) * SEQ + 8 * sch;
    u32x4 rk = *(const u32x4*)gk, rv = *(const u32x4*)gv;
    {
        const int nreg = (32 * nstep + 63) >> 6;
        const unsigned kept = __float_as_uint(-P.bc);
        select_row(sc + (2 * wid) * SCS, q0 + 2 * wid, nreg, lane, kept);
        select_row(sc + (2 * wid + 1) * SCS, q0 + 2 * wid + 1, nreg, lane, kept);
    }
    __syncthreads();
    {
        f32x4 o[HPW][4]; float ls[HPW];
#pragma unroll
        for (int h = 0; h < HPW; ++h) { ls[h] = 0.f;
#pragma unroll
            for (int dt = 0; dt < 4; ++dt) o[h][dt] = (f32x4){0.f, 0.f, 0.f, 0.f}; }
        const float cl = 0.125f * 1.44269504f;
        const LAS float* brow = (const LAS float*)sc + ln * SCS + 4 * lg;
        LAS unsigned char* lk = lds + KT_OFF + srow_ * 144 + sch * 16;
        LAS unsigned char* lv = lds + VT_OFF + srow_ * 144 + sch * 16;
        const LAS unsigned char* fk = lds + KT_OFF + (32 * ksp + ln) * 144 + 16 * lg;
        const LAS unsigned char* fv = lds + VT_OFF + ln * 144 + 64 * ksp + 8 * lg;
        const int ntile = (nstep + 1) >> 1;
        for (int tt = 0; tt < ntile; ++tt) {
            __syncthreads();
            *(LAS u32x4*)lk = rk; *(LAS u32x4*)lv = rv;
            __syncthreads();
            if (tt + 1 < ntile) { gk += 64 * 64; gv += 64; rk = *(const u32x4*)gk; rv = *(const u32x4*)gv; }
            const int st = 2 * tt + ksp;
            if (st < nstep) {
                const bf16x8 k0 = *(const LAS bf16x8*)fk, k1 = *(const LAS bf16x8*)(fk + 64), k2 = *(const LAS bf16x8*)(fk + 16 * 144), k3 = *(const LAS bf16x8*)(fk + 16 * 144 + 64);
                union { u32x4 u; bf16x8 v; } va[4];
#pragma unroll
                for (int dt = 0; dt < 4; ++dt) { const u32x2 v0 = *(const LAS u32x2*)(fv + dt * 16 * 144), v1 = *(const LAS u32x2*)(fv + dt * 16 * 144 + 32); va[dt].u.x = v0.x; va[dt].u.y = v0.y; va[dt].u.z = v1.x; va[dt].u.w = v1.y; }
                const f32x4 ba = *(const LAS f32x4*)(brow + 32 * st), bb = *(const LAS f32x4*)(brow + 32 * st + 16);
#pragma unroll
                for (int h = 0; h < HPW; ++h) {
                    f32x4 sa = {0.f, 0.f, 0.f, 0.f}, sb = {0.f, 0.f, 0.f, 0.f};
                    sa = __builtin_amdgcn_mfma_f32_16x16x32_bf16(k0, qb[h][0], sa, 0, 0, 0); sa = __builtin_amdgcn_mfma_f32_16x16x32_bf16(k1, qb[h][1], sa, 0, 0, 0);
                    sb = __builtin_amdgcn_mfma_f32_16x16x32_bf16(k2, qb[h][0], sb, 0, 0, 0); sb = __builtin_amdgcn_mfma_f32_16x16x32_bf16(k3, qb[h][1], sb, 0, 0, 0);
                    float pa[4], pb[4], ps = 0.f;
#pragma unroll
                    for (int e = 0; e < 4; ++e) { pa[e] = __builtin_amdgcn_exp2f(sa[e] * cl + ba[e]); pb[e] = __builtin_amdgcn_exp2f(sb[e] * cl + bb[e]); ps += pa[e] + pb[e]; }
                    ls[h] += ps;
                    union { u32x4 u; bf16x8 v; } p8;
                    p8.u.x = pg8::cvt_pk_bf16(pa[0], pa[1]); p8.u.y = pg8::cvt_pk_bf16(pa[2], pa[3]); p8.u.z = pg8::cvt_pk_bf16(pb[0], pb[1]); p8.u.w = pg8::cvt_pk_bf16(pb[2], pb[3]);
#pragma unroll
                    for (int dt = 0; dt < 4; ++dt) o[h][dt] = __builtin_amdgcn_mfma_f32_16x16x32_bf16(va[dt].v, p8.v, o[h][dt], 0, 0, 0);
                }
            }
        }
        __syncthreads();
        LAS float* cb = (LAS float*)lds;
        if (ksp != 0) {
            LAS float* c0 = cb + (size_t)((hg * (NKS - 1) + ksp - 1) * CBW) * 64 + lane;
#pragma unroll
            for (int h = 0; h < HPW; ++h) {
#pragma unroll
                for (int dt = 0; dt < 4; ++dt)
#pragma unroll
                    for (int e = 0; e < 4; ++e) c0[((h * 4 + dt) * 4 + e) * 64] = o[h][dt][e];
                c0[(HPW * 16 + h) * 64] = ls[h];
            }
        }
        __syncthreads();
        if (ksp == 0) {
#pragma unroll
            for (int j = 0; j < NKS - 1; ++j) {
                const LAS float* c0 = cb + (size_t)((hg * (NKS - 1) + j) * CBW) * 64 + lane;
#pragma unroll
                for (int h = 0; h < HPW; ++h) {
#pragma unroll
                    for (int dt = 0; dt < 4; ++dt)
#pragma unroll
                        for (int e = 0; e < 4; ++e) o[h][dt][e] += c0[((h * 4 + dt) * 4 + e) * 64];
                    ls[h] += c0[(HPW * 16 + h) * 64];
                }
            }
#pragma unroll
            for (int h = 0; h < HPW; ++h) {
                float l = ls[h]; l += __shfl_xor(l, 16); l += __shfl_xor(l, 32);
                const float inv = 1.0f / l;
                bf16_t* py = P.Y + (tb + q0 + ln) * 512 + (HPW * hg + h) * 64 + 4 * lg;
#pragma unroll
                for (int dt = 0; dt < 4; ++dt) *(u32x2*)(py + 16 * dt) = pack4(o[h][dt] * inv);
            }
        }
    }
    __syncthreads();
}

__device__ __forceinline__ void fold_bias(const float* pb, const float* psc, const float* pp, float* BIASF, int tidx, int nthr) {
    for (int o = tidx; o < DM * 16; o += nthr) {
        const int n = o >> 4, kp = o & 15; float acc = 0.f;
#pragma unroll 8
        for (int j = 0; j < 32; ++j) { const int k = 32 * kp + j; acc += (pb[k] * psc[k]) * pp[(size_t)k * DM + n]; }
        acc += __shfl_xor(acc, 1); acc += __shfl_xor(acc, 2); acc += __shfl_xor(acc, 4); acc += __shfl_xor(acc, 8);
        if (kp == 0) BIASF[n] = acc;
    }
}

#define XB_TMO      128
#define XB_XCNT(j)  (256  + 64 * (j))
#define XB_XSUB(j)  (1280 + 64 * (j))
#define XB_XGEN(j)  (2304 + 64 * (j))
#define XB_TOP      3328
#define XB_TOPGEN   3392
#define XCD_BAR_WORDS 3456
#define XB_SPIN_CAP (1u << 18)

__device__ __forceinline__ unsigned xb_ld(unsigned* p)              { return __hip_atomic_load(p, __ATOMIC_RELAXED, __HIP_MEMORY_SCOPE_AGENT); }
__device__ __forceinline__ unsigned xb_add(unsigned* p, unsigned v) { return __hip_atomic_fetch_add(p, v, __ATOMIC_RELAXED, __HIP_MEMORY_SCOPE_AGENT); }
__device__ __forceinline__ unsigned xb_xcc_id() { return (unsigned)__builtin_amdgcn_s_getreg((3 << 11) | 20) & 0xFu; }
#define XB_SPIN(cond, bar) do { unsigned _sp = 0; while (cond) { __builtin_amdgcn_s_sleep(1); \
    if ((++_sp & 255u) == 0u) { if (xb_ld(&(bar)[XB_TMO])) break; if (_sp > XB_SPIN_CAP) { atomicAdd(&(bar)[XB_TMO], 1u); break; } } } } while (0)

struct XcdBarrier {
    unsigned* bar; unsigned x;
    volatile LAS unsigned* st;
};

__device__ __forceinline__ XcdBarrier xcd_barrier_post(unsigned* bar, volatile LAS unsigned* st) {
    XcdBarrier b; b.bar = bar; b.x = xb_xcc_id(); b.st = st;
    if (threadIdx.x == 0) (void)xb_add(&bar[XB_XCNT(b.x)], 1u);
    return b;
}
__device__ __forceinline__ void xcd_barrier_complete(unsigned* bar, unsigned x, unsigned& nloc, unsigned& nx) {
    const unsigned G = gridDim.x * gridDim.y * gridDim.z;
    unsigned sum, cnt, mine, sp = 0u;
    for (;;) {
        sum = 0u; cnt = 0u; mine = 0u;
#pragma unroll
        for (unsigned j = 0; j < 16; ++j) { const unsigned c = xb_ld(&bar[XB_XCNT(j)]); sum += c; cnt += (c > 0u) ? 1u : 0u; mine = (j == x) ? c : mine; }
        if (sum == G) break;
        __builtin_amdgcn_s_sleep(1);
        if ((++sp & 255u) == 0u) { if (xb_ld(&bar[XB_TMO])) break; if (sp > XB_SPIN_CAP) { atomicAdd(&bar[XB_TMO], 1u); break; } }
    }
    nloc = mine > 0u ? mine : 1u; nx = cnt > 0u ? cnt : 1u;
}

__device__ __forceinline__ void xcd_barrier(const XcdBarrier& b) {
    asm volatile("s_waitcnt vmcnt(0)" ::: "memory");
    __syncthreads();
    if (threadIdx.x == 0) {
        unsigned* bar = b.bar;
        __builtin_amdgcn_s_waitcnt(0);
        unsigned nloc = b.st[0], nx = b.st[1];
        if (nloc == 0u) { xcd_barrier_complete(bar, b.x, nloc, nx); b.st[0] = nloc; b.st[1] = nx; }
        const unsigned old = xb_add(&bar[XB_XSUB(b.x)], 1u);
        const unsigned gen = old / nloc;
        if (old + 1u == (gen + 1u) * nloc) {
            __builtin_amdgcn_fence(__ATOMIC_RELEASE, "agent");
            asm volatile("s_waitcnt vmcnt(0)" ::: "memory");
            const unsigned og = xb_add(&bar[XB_TOP], 1u);
            const unsigned tg = og / nx;
            if (og + 1u == (tg + 1u) * nx) xb_add(&bar[XB_TOPGEN], 1u);
            else XB_SPIN(xb_ld(&bar[XB_TOPGEN]) == tg, bar);
            __builtin_amdgcn_fence(__ATOMIC_ACQUIRE, "agent");
            xb_add(&bar[XB_XGEN(b.x)], 1u);
            asm volatile("s_waitcnt vmcnt(0)" ::: "memory");
        } else {
            XB_SPIN(xb_ld(&bar[XB_XGEN(b.x)]) == gen, bar);
            __builtin_amdgcn_fence(__ATOMIC_ACQUIRE, "agent");
            asm volatile("s_waitcnt vmcnt(0)" ::: "memory");
        }
    }
    __syncthreads();
}

struct Args { const void* in[20]; float* out; unsigned char* ws; int ph_lo, ph_hi; };
#ifndef MK_N_LAUNCHES
#define MK_N_LAUNCHES 1
#endif
constexpr int NPHASE = 10;

__global__ void __launch_bounds__(512) fwd_kernel(Args a) {
    extern __shared__ __attribute__((aligned(16))) unsigned char lds_raw[];
    LAS unsigned char* lds = (LAS unsigned char*)lds_raw;
    const int tid = threadIdx.x, lane = tid & 63, wid = __builtin_amdgcn_readfirstlane(tid >> 6);
    const int G = gridDim.x, bx = blockIdx.x;
    const int lo = a.ph_lo, hi = a.ph_hi;
    unsigned char* ws = a.ws;
    const float* x = (const float*)a.in[0]; const int* positions = (const int*)a.in[1];
    float* out = a.out;
    bf16_t* W13A = (bf16_t*)(ws + OFF_W13A); bf16_t* W2A = (bf16_t*)(ws + OFF_W2A); bf16_t* WIN = (bf16_t*)(ws + OFF_WIN); bf16_t* WPOOL = (bf16_t*)(ws + OFF_WPOOL);
    bf16_t* WPA = (bf16_t*)(ws + OFF_WPA); bf16_t* WPP = (bf16_t*)(ws + OFF_WPP); bf16_t* WOUT = (bf16_t*)(ws + OFF_WOUT); bf16_t* W13B = (bf16_t*)(ws + OFF_W13B); bf16_t* W2B = (bf16_t*)(ws + OFF_W2B);
    float* CS = (float*)(ws + OFF_ROPE); float* SN = CS + (size_t)T * 32; float* SS = (float*)(ws + OFF_SS);
    bf16_t* AB0 = (bf16_t*)(ws + OFF_AB0); bf16_t* AB1 = (bf16_t*)(ws + OFF_AB1);
    bf16_t* SGA = (bf16_t*)(ws + OFF_SGA); bf16_t* SGP = (bf16_t*)(ws + OFF_SGP); bf16_t* Qb = (bf16_t*)(ws + OFF_Q); bf16_t* QIb = (bf16_t*)(ws + OFF_QI);
    float* Ub = (float*)(ws + OFF_U); bf16_t* Kb = (bf16_t*)(ws + OFF_K); bf16_t* KIb = (bf16_t*)(ws + OFF_KI); bf16_t* VTb = (bf16_t*)(ws + OFF_VT); float* WIb = (float*)(ws + OFF_WI);
    bf16_t* Gb = (bf16_t*)(ws + OFF_G); bf16_t* M1 = (bf16_t*)(ws + OFF_M1); float* BIASF = (float*)(ws + OFF_BIASF); bf16_t* WPPF = (bf16_t*)(ws + OFF_WPPF);
#if MK_N_LAUNCHES == 1
    cg::grid_group grid = cg::this_grid();
    if (tid < 4) ((LAS unsigned*)(lds + LDS_BYTES - 16))[tid] = 0u;
    __syncthreads();
    if (hi > NPHASE) grid.sync();
    const XcdBarrier xbar = xcd_barrier_post((unsigned*)(ws + OFF_BAR), (volatile LAS unsigned*)(lds + LDS_BYTES - 16));
#define SEAM(k) do { if (lo <= (k) && (k) + 1 < hi) xcd_barrier(xbar); } while (0)
#else
#define SEAM(k) do { } while (0)
#endif
#define IN(k) (lo <= (k) && (k) < hi)

    if (IN(0)) {
        LAS float* scr = (LAS float*)(lds + wid * 8448);
        const int gw = bx * 8 + wid, NGW = G * 8;
        constexpr int I_UP = (DM / 64) * (NUP / 32), I_DN = (FF / 64) * (DM / 32), I_PL = (512 / 64) * (512 / 32), I_PR = (512 / 64) * (DM / 32);
        constexpr int NITEMS = I_UP + I_DN + I_PL + 2 * I_PR;
        for (int it = gw; it < NITEMS; it += NGW) {
            int r = it;
            if (r < I_UP) { cvt_item<CV_UP>((const float*)a.in[3], (const float*)a.in[4], DM, NUP / 32, W13A, scr, r, lane); continue; } r -= I_UP;
            if (r < I_DN) { cvt_item<CV_NAT>((const float*)a.in[5], nullptr, FF, DM / 32, W2A, scr, r, lane); continue; } r -= I_DN;
            if (r < I_PR) { cvt_item<CV_NAT>((const float*)a.in[13], nullptr, 512, DM / 32, WPA, scr, r, lane); continue; } r -= I_PR;
            if (r < I_PR) { cvt_item<CV_NAT>((const float*)a.in[14], nullptr, 512, DM / 32, WPP, scr, r, lane); continue; } r -= I_PR;
            cvt_item<CV_POOL>((const float*)a.in[10], (const float*)a.in[12], 512, 512 / 32, WPOOL, scr, r, lane);
        }
        const float* g1 = (const float*)a.in[2];
        for (int m = 2 * gw; m < T; m += 2 * NGW) {
            const f32x4* xr = (const f32x4*)(x + (size_t)m * DM) + lane; f32x4 v[2][4]; float s[2] = {0.f, 0.f};
#pragma unroll
            for (int q = 0; q < 2; ++q)
#pragma unroll
                for (int j = 0; j < 4; ++j) v[q][j] = xr[q * (DM / 4) + 64 * j];
#pragma unroll
            for (int q = 0; q < 2; ++q) {
#pragma unroll
                for (int j = 0; j < 4; ++j) s[q] += (v[q][j][0] * v[q][j][0] + v[q][j][1] * v[q][j][1]) + (v[q][j][2] * v[q][j][2] + v[q][j][3] * v[q][j][3]);
                const float rinv = 1.0f / sqrtf(wave_sum(s[q]) * (1.0f / DM) + EPS);
#pragma unroll
                for (int j = 0; j < 4; ++j) { const f32x4 gv = *((const f32x4*)g1 + lane + 64 * j); *((u32x2*)(AB0 + (size_t)(m + q) * DM) + lane + 64 * j) = pack4(v[q][j] * rinv * gv); }
            }
        }
        asm volatile("s_waitcnt vmcnt(0) lgkmcnt(0)" ::: "memory");
        __syncthreads();
    }
    SEAM(0);
    if (IN(1)) { pg8::Gemm g{AB0, W13A, T, NUP, DM}; pg8::StaticOrder S; S.init(T, NUP, G, bx); EpiUp E{Gb, nullptr}; pg8::gemm_phase<EpiUp, pg8::StaticOrder>(lds, g, S, E, nullptr);
        const int nun = (T / 256) * (NUP / 256), rem = nun % G, ntail = rem ? G - rem : G, ti = rem ? bx - rem : bx;
        if (ti >= 0) {
            if (ti < 8) { pg8::Gemm g2{WPP, WPOOL, DM, 512, 512}; pg8::StaticOrder S2; S2.init(DM, 512, 8, ti); EpiPlain E2{WPPF, 512}; pg8::gemm_phase<EpiPlain, pg8::StaticOrder>(lds, g2, S2, E2, nullptr); }
            else {
            if (ti < 40) fold_bias((const float*)a.in[11], (const float*)a.in[12], (const float*)a.in[14], BIASF, (ti - 8) * 512 + tid, 32 * 512);
            if (ntail > 8) {
                const int nw = (ntail - 8) * 8, w0 = (ti - 8) * 8 + wid; LAS float* scr = (LAS float*)(lds + wid * 8448);
                for (int it = w0; it < (DM / 64) * (NIN / 32); it += nw) cvt_item<CV_IN>((const float*)a.in[7], nullptr, DM, NIN / 32, WIN, scr, it, lane, (const float*)a.in[6]);
                for (int i = (ti - 8) * 512 + tid; i < T * 32; i += (ntail - 8) * 512) {
                    const int tok = i >> 5, f = i & 31;
                    const float ang = (float)positions[tok] * INV_FREQ[f];
                    const double rev = (double)ang * 0.15915494309189535; const float fr = (float)(rev - __builtin_rint(rev));
                    CS[i] = __builtin_amdgcn_cosf(fr); SN[i] = __builtin_amdgcn_sinf(fr);
                }
            }
            }
        }
    }
    SEAM(1);
    bf16_t* XB = (bf16_t*)out;
    if (IN(2)) { pg8::Gemm g{Gb, W2A, T, DM, FF}; pg8::StaticOrder S; S.init(T, DM, G, bx); EpiRes<2> E{x, out, ws}; pg8::gemm_phase<EpiRes<2>, pg8::StaticOrder>(lds, g, S, E, nullptr); }
    SEAM(2);
    if (IN(3)) { pg8::Gemm g{XB, WIN, T, NIN, DM}; pg8::StaticOrder S; S.init(T, NIN, G, bx);
        EpiIn E{SS, CS, SN, (const float*)a.in[8], (const float*)a.in[9], Qb, QIb, Kb, KIb, VTb, WIb, Ub, SGA, SGP};
        pg8::gemm_phase<EpiIn, pg8::StaticOrder>(lds, g, S, E, nullptr);
        const int nun = (T / 256) * (NIN / 256), rem = nun % G, ntail = rem ? G - rem : G, ti = rem ? bx - rem : bx;
        if (ti >= 0) {
            constexpr int I_UP = (DM / 64) * (NUP / 32), I_DN = (FF / 64) * (DM / 32), I_OUT = (DM / 64) * (DM / 32);
            const int nw = ntail * 8, w0 = ti * 8 + wid; LAS float* scr = (LAS float*)(lds + wid * 8448);
            for (int it = w0; it < I_UP + I_DN + I_OUT; it += nw) {
                int r = it;
                if (r < I_UP) { cvt_item<CV_UP>((const float*)a.in[17], (const float*)a.in[18], DM, NUP / 32, W13B, scr, r, lane, (const float*)a.in[16]); continue; } r -= I_UP;
                if (r < I_DN) { cvt_item<CV_NAT>((const float*)a.in[19], nullptr, FF, DM / 32, W2B, scr, r, lane); continue; } r -= I_DN;
                cvt_item<CV_NAT>((const float*)a.in[15], nullptr, DM, DM / 32, WOUT, scr, r, lane);
            }
        }
    }
    SEAM(3);
    if (IN(4)) {
        bf16_t* PLD = AB0 + (size_t)T * 512;
        for (int ch = bx; ch < T / 32; ch += G) {
            const int g = tid >> 7, win = 2 << g, t0 = ch * 32, pos0 = t0 % SEQ;
            float h[47];
#pragma unroll
            for (int rr = 0; rr < 47; ++rr) h[rr] = (pos0 + rr - 15 >= 0) ? Ub[(size_t)(t0 + rr - 15) * 512 + tid] : 0.f;
#pragma unroll
            for (int r = 0; r < 32; ++r) {
                const int n = (pos0 + r + 1 < win) ? pos0 + r + 1 : win; float s = 0.f;
#pragma unroll
                for (int j = 0; j < 16; ++j) s += (j < n) ? h[15 + r - j] : 0.f;
                PLD[(size_t)(t0 + r) * 512 + tid] = (bf16_t)(pg8::cvt_pk_bf16(s / (float)n - h[15 + r], 0.f) & 0xffffu);
            }
        }
        float gq = fabsf(((const float*)a.in[8])[lane]), gk = fabsf(((const float*)a.in[9])[lane]);
#pragma unroll
        for (int o_ = 1; o_ < 64; o_ <<= 1) { gq = fmaxf(gq, __shfl_xor(gq, o_)); gk = fmaxf(gk, __shfl_xor(gk, o_)); }
        const P4Ptrs P{Qb, QIb, Kb, KIb, VTb, WIb, AB0, 8.0f * gq * gk * 1.02f * 1.44269504f};
        for (int i = 0; ; ++i) {
            const int sidx = i * G + bx; if (sidx >= T / 16) break;
            const int rnd = sidx / 256, j = sidx % 256, s2 = rnd * 256 + ((rnd & 1) ? 255 - j : j);
            p4_unit(lds, P, s2 & 7, (s2 >> 3) * 16, wid, lane);
        }
    }
    SEAM(4);
    if (IN(6)) {
        { pg8::Gemm g{AB0, WPA, T, DM, 512}; pg8::StaticOrder S; S.init(T, DM, G, bx); EpiProj<0> E{SGA, M1, AB1, nullptr}; pg8::gemm_phase<EpiProj<0>, pg8::StaticOrder>(lds, g, S, E, nullptr); }
        { pg8::Gemm g{AB0 + (size_t)T * 512, WPPF, T, DM, 512}; pg8::StaticOrder S; S.init(T, DM, G, bx); EpiProj<1> E{SGP, M1, AB1, BIASF}; pg8::gemm_phase<EpiProj<1>, pg8::StaticOrder>(lds, g, S, E, nullptr); }
    }
    SEAM(6);
    if (IN(7)) { pg8::Gemm g{AB1, WOUT, T, DM, DM}; pg8::StaticOrder S; S.init(T, DM, G, bx); EpiRes<7> E{x, out, ws}; pg8::gemm_phase<EpiRes<7>, pg8::StaticOrder>(lds, g, S, E, nullptr); }
    SEAM(7);
    if (IN(8)) { pg8::Gemm g{AB0, W13B, T, NUP, DM}; pg8::StaticOrder S; S.init(T, NUP, G, bx); EpiUp E{Gb, SS}; pg8::gemm_phase<EpiUp, pg8::StaticOrder>(lds, g, S, E, nullptr); }
    SEAM(8);
    if (IN(9)) { pg8::Gemm g{Gb, W2B, T, DM, FF}; pg8::StaticOrder S; S.init(T, DM, G, bx); EpiRes<9> E{x, out, ws}; pg8::gemm_phase<EpiRes<9>, pg8::StaticOrder>(lds, g, S, E, nullptr); }
#undef IN
#undef SEAM
}

extern "C" void kernel_launch(void* const* d_in, const int* in_sizes, int n_in, void* d_out, int out_size, void* d_ws, size_t ws_size, hipStream_t stream) {
    static int grid = 0;
    if (grid == 0) {
        if (n_in != 20 || out_size != T * DM || ws_size < WS_END) { fprintf(stderr, "kernel_launch: unexpected shapes (n_in %d out %d ws %zu need %zu)\n", n_in, out_size, ws_size, (size_t)WS_END); grid = -1; return; }
        int dev = 0, cus = 0, per_cu = 0;
        (void)hipGetDevice(&dev); (void)hipDeviceGetAttribute(&cus, hipDeviceAttributeMultiprocessorCount, dev);
        if (hipFuncSetAttribute((const void*)fwd_kernel, hipFuncAttributeMaxDynamicSharedMemorySize, LDS_BYTES) != hipSuccess) { fprintf(stderr, "kernel_launch: hipFuncSetAttribute failed\n"); grid = -1; return; }
        if (hipOccupancyMaxActiveBlocksPerMultiprocessor(&per_cu, (const void*)fwd_kernel, 512, LDS_BYTES) != hipSuccess || per_cu < 1) per_cu = 1;
        (void)hipGetLastError();
        grid = cus * 1;
        fprintf(stderr, "kernel_launch: grid %d (per_cu query %d)\n", grid, per_cu);
    }
    if (grid < 0) return;
    Args a{};
    for (int i = 0; i < 20; ++i) a.in[i] = d_in[i];
    a.out = (float*)d_out; a.ws = (unsigned char*)d_ws;
#if MK_N_LAUNCHES == 1
    a.ph_lo = 0; a.ph_hi = NPHASE;
    void* args[] = {&a};
    if (hipMemsetAsync((char*)d_ws + OFF_BAR, 0, 16384, stream) != hipSuccess) return;
    const hipError_t e = hipLaunchCooperativeKernel((const void*)fwd_kernel, dim3(grid), dim3(512), args, LDS_BYTES, stream);
    if (e != hipSuccess) fprintf(stderr, "kernel_launch: cooperative launch failed: %s\n", hipGetErrorString(e));
#else
    for (int p = 0; p < NPHASE; ++p) { a.ph_lo = p; a.ph_hi = p + 1; hipLaunchKernelGGL(fwd_kernel, dim3(grid), dim3(512), LDS_BYTES, stream, a); }
#endif
}
```
